# Optimizing an MI355X kernel written in HIP

```python
import math
import jax, jax.numpy as jnp
from jax import lax
import numpy as np

D_MODEL = 2048
BATCH = 2
SEQ = 16384
DEPTH = 1
DEC_BATCH = 2
DEC_SEQ = 8192
PAST_LEN = 128

D_HYENA = 1024
HYENA_ORDER = 2
SHORT_CONV = 3
FILTER_EMB = 33
FILTER_HIDDEN = 64
FAST_DECAY_PCT = 0.3
SLOW_DECAY_PCT = 1.5
DECAY_TARGET = 1e-2
FILTER_GAIN = 0.02
HEAD_DIM = 128
HEADS_PER_GROUP = 4
ATT_GROUPS = ((128, 1), (512, 4), (2048, 16))
N_GROUPS = len(ATT_GROUPS)
D_ATT = N_GROUPS * HEADS_PER_GROUP * HEAD_DIM
D_ATT_OUT = HEADS_PER_GROUP * HEAD_DIM
ROPE_DIM = HEAD_DIM // 4
ROPE_THETA = 500000.0
N_BRANCH = 2
D_IN_PROJ = 3 * D_HYENA + 3 * D_ATT + N_BRANCH * D_MODEL
D_FF = 5632
EPS = 1e-6
NEG_INF = -1e30

kernel_name = 'hybrid_hyena_dilated_attn_encoder'


def rmsnorm(x, g):
    xf = x.astype(jnp.float32)
    y = xf * lax.rsqrt(jnp.mean(xf * xf, axis=-1, keepdims=True) + EPS)
    return (y * g.astype(jnp.float32)).astype(x.dtype)


def swiglu(x, w_gate, w_up, w_down):
    return (jax.nn.silu(x @ w_gate) * (x @ w_up)) @ w_down


def short_conv(x, w, b):
    L = x.shape[1]
    p = SHORT_CONV // 2
    xp = jnp.pad(x, ((0, 0), (p, p), (0, 0)))
    y = xp[:, 0:L] * w[0]
    for i in range(1, SHORT_CONV):
        y = y + xp[:, i:i + L] * w[i]
    return y + b


def hyena_filters(L, fw1, fb1, fw2, fb2, fw3, fb3, fw4, ffreq):
    f32 = jnp.float32
    t = jnp.linspace(0.0, 1.0, L, dtype=f32)[:, None]
    bands = (FILTER_EMB - 1) // 2
    w = (2.0 * math.pi / L) * jnp.arange(L, dtype=f32)[:, None]
    f = jnp.linspace(1e-4, bands - 1, bands, dtype=f32)[None, :]
    z = jnp.concatenate([t, jnp.cos(f * w), -jnp.sin(f * w)], axis=-1)
    freq = ffreq.astype(f32)
    h = jnp.sin(freq * (z @ fw1.astype(f32) + fb1.astype(f32)))
    h = jnp.sin(freq * (h @ fw2.astype(f32) + fb2.astype(f32)))
    h = jnp.sin(freq * (h @ fw3.astype(f32) + fb3.astype(f32)))
    h = h @ fw4.astype(f32)
    max_decay = math.log(DECAY_TARGET) / FAST_DECAY_PCT
    min_decay = math.log(DECAY_TARGET) / SLOW_DECAY_PCT
    deltas = jnp.abs(jnp.linspace(min_decay, max_decay, D_HYENA, dtype=f32))
    decay = jnp.exp(-t * deltas)
    return h.reshape(L, HYENA_ORDER, 2, D_HYENA) * decay[:, None, None, :]


def two_sided_longconv(z, h_fwd, h_bwd, bias):
    L, C = h_fwd.shape
    k = jnp.concatenate([h_fwd, jnp.zeros((1, C), jnp.float32), h_bwd[:0:-1]], axis=0)
    kf = jnp.fft.rfft(k, axis=0)
    zf = jnp.fft.rfft(z, n=2 * L, axis=1)
    y = jnp.fft.irfft(zf * kf[None], n=2 * L, axis=1)[:, :L]
    return y + z * bias


def hyena_mixer(hy_in, conv_w, conv_b, fw1, fb1, fw2, fb2, fw3, fb3, fw4, ffreq, hy_bias):
    L = hy_in.shape[1]
    zs = short_conv(hy_in, conv_w, conv_b).astype(jnp.float32)
    v, x1, x2 = jnp.split(zs, 3, axis=-1)
    h = hyena_filters(L, fw1, fb1, fw2, fb2, fw3, fb3, fw4, ffreq)
    y = v
    for n, gate in enumerate((x1, x2)):
        y = gate * two_sided_longconv(y, h[:, n, 0], h[:, n, 1], hy_bias[n].astype(jnp.float32))
    return y


def rope_partial(x, pos):
    half = ROPE_DIM // 2
    inv_freq = jnp.power(ROPE_THETA, -jnp.arange(half, dtype=jnp.float32) / half)
    ang = pos[:, None] * inv_freq[None, :]
    shape = (1, x.shape[1]) + (1,) * (x.ndim - 3) + (half,)
    cos = jnp.cos(ang).reshape(shape)
    sin = jnp.sin(ang).reshape(shape)
    xr = x[..., :ROPE_DIM].astype(jnp.float32)
    xa, xb = xr[..., :half], xr[..., half:]
    rot = jnp.concatenate([xa * cos - xb * sin, xb * cos + xa * sin], axis=-1)
    return jnp.concatenate([rot.astype(x.dtype), x[..., ROPE_DIM:]], axis=-1)


def dilated_window_attention(q, k, v, window, dilation):
    Bsz, L, H, Dh = q.shape
    radius = window // (2 * dilation)
    blk = radius
    span = dilation * blk
    Lp = -(-L // span) * span
    Ls = Lp // dilation
    nb = Ls // blk

    def to_blocks(t):
        t = jnp.pad(t, ((0, 0), (0, Lp - L), (0, 0), (0, 0)))
        t = t.reshape(Bsz, Ls, dilation, H, Dh).transpose(0, 2, 1, 3, 4)
        return t.reshape(Bsz, dilation, nb, blk, H, Dh)

    def neighbours(t):
        tp = jnp.pad(t, ((0, 0), (0, 0), (1, 1), (0, 0), (0, 0), (0, 0)))
        return jnp.concatenate([tp[:, :, :-2], tp[:, :, 1:-1], tp[:, :, 2:]], axis=3)

    qb = to_blocks(q)
    kn = neighbours(to_blocks(k))
    vn = neighbours(to_blocks(v))
    scores = jnp.einsum('brnqhd,brnkhd->brnhqk', qb, kn, preferred_element_type=jnp.float32)
    qi = jnp.arange(blk)
    ki = jnp.arange(3 * blk) - blk
    band = jnp.abs(ki[None, :] - qi[:, None]) <= radius
    strided_key = jnp.arange(nb)[:, None] * blk + ki[None, :]
    key_pos = strided_key[None] * dilation + jnp.arange(dilation)[:, None, None]
    valid = (strided_key >= 0)[None] & (key_pos < L)
    mask = band[None, None] & valid[:, :, None, :]
    scores = jnp.where(mask[None, :, :, None], scores, NEG_INF)
    m = jnp.max(scores, axis=-1, keepdims=True)
    p = jnp.exp(scores - m)
    s = jnp.sum(p, axis=-1, keepdims=True)
    out = jnp.einsum('brnhqk,brnkhd->brnqhd', (p / s).astype(v.dtype), vn,
                     preferred_element_type=jnp.float32)
    lse = (m + jnp.log(s))[..., 0]
    out = out.reshape(Bsz, dilation, Ls, H, Dh).transpose(0, 2, 1, 3, 4).reshape(Bsz, Lp, H, Dh)[:, :L]
    lse = lse.transpose(0, 1, 2, 4, 3).reshape(Bsz, dilation, Ls, H).transpose(0, 2, 1, 3).reshape(Bsz, Lp, H)[:, :L]
    return out, lse


def token_mixer(u, w_in, hy_conv_w, hy_conv_b, fw1, fb1, fw2, fb2, fw3, fb3, fw4, ffreq, hy_bias,
                w_hy_proj, w_att_proj, w_out):
    Bsz, L, _ = u.shape
    proj = u @ w_in
    c0 = 3 * D_HYENA
    c1 = c0 + 3 * D_ATT
    hy_in = proj[..., :c0]
    qkv = proj[..., c0:c1].reshape(Bsz, L, 3, N_GROUPS, HEADS_PER_GROUP, HEAD_DIM)
    gates = jax.nn.sigmoid(proj[..., c1:].astype(jnp.float32)).reshape(Bsz, L, N_BRANCH, D_MODEL)
    a = hyena_mixer(hy_in, hy_conv_w, hy_conv_b, fw1, fb1, fw2, fb2, fw3, fb3, fw4, ffreq, hy_bias)
    a = a.astype(u.dtype) @ w_hy_proj
    pos = jnp.arange(L, dtype=jnp.float32)
    q = rope_partial(qkv[:, :, 0], pos) * (HEAD_DIM ** -0.5)
    k = rope_partial(qkv[:, :, 1], pos)
    v = qkv[:, :, 2]
    outs = []
    lses = []
    for g, (window, dilation) in enumerate(ATT_GROUPS):
        o, s = dilated_window_attention(q[:, :, g], k[:, :, g], v[:, :, g], window, dilation)
        outs.append(o)
        lses.append(s)
    wts = jax.nn.softmax(jnp.stack(lses, axis=0), axis=0)
    att = jnp.sum(wts[..., None] * jnp.stack(outs, axis=0), axis=0)
    b = att.reshape(Bsz, L, D_ATT_OUT).astype(u.dtype) @ w_att_proj
    merged = (gates[:, :, 0] * a + gates[:, :, 1] * b).astype(u.dtype)
    return merged @ w_out


def encoder_layer(x, ffn1_pre_g, ffn1_post_g, ffn1_w_gate, ffn1_w_up, ffn1_w_down,
                  mix_pre_g, mix_post_g, w_in, hy_conv_w, hy_conv_b,
                  filt_w1, filt_b1, filt_w2, filt_b2, filt_w3, filt_b3, filt_w4, filt_freq, hy_bias,
                  w_hy_proj, w_att_proj, w_out,
                  ffn2_pre_g, ffn2_post_g, ffn2_w_gate, ffn2_w_up, ffn2_w_down):
    x = x + 0.5 * rmsnorm(swiglu(rmsnorm(x, ffn1_pre_g), ffn1_w_gate, ffn1_w_up, ffn1_w_down), ffn1_post_g)
    mix = token_mixer(rmsnorm(x, mix_pre_g), w_in, hy_conv_w, hy_conv_b,
                      filt_w1, filt_b1, filt_w2, filt_b2, filt_w3, filt_b3, filt_w4, filt_freq, hy_bias,
                      w_hy_proj, w_att_proj, w_out)
    x = x + rmsnorm(mix, mix_post_g)
    x = x + 0.5 * rmsnorm(swiglu(rmsnorm(x, ffn2_pre_g), ffn2_w_gate, ffn2_w_up, ffn2_w_down), ffn2_post_g)
    return x


def setup_inputs(seed: int = 0) -> dict:
    key = jax.random.key(seed)
    ks = jax.random.split(key, 29)
    f32 = jnp.float32

    def nrm(k, shape, scale):
        return jax.random.normal(k, shape, f32) * scale

    def gain(k, d):
        return 1.0 + nrm(k, (DEPTH, d), 0.02)

    return {
        'x_prompt': nrm(ks[0], (BATCH, SEQ, D_MODEL), 1.0),
        'x_sample': nrm(ks[1], (DEC_BATCH, DEC_SEQ, D_MODEL), 1.0),
        'ffn1_pre_g': gain(ks[2], D_MODEL),
        'ffn1_post_g': gain(ks[3], D_MODEL),
        'ffn1_w_gate': nrm(ks[4], (DEPTH, D_MODEL, D_FF), D_MODEL ** -0.5),
        'ffn1_w_up': nrm(ks[5], (DEPTH, D_MODEL, D_FF), D_MODEL ** -0.5),
        'ffn1_w_down': nrm(ks[6], (DEPTH, D_FF, D_MODEL), D_FF ** -0.5),
        'mix_pre_g': gain(ks[7], D_MODEL),
        'mix_post_g': gain(ks[8], D_MODEL),
        'w_in': nrm(ks[9], (DEPTH, D_MODEL, D_IN_PROJ), D_MODEL ** -0.5),
        'hy_conv_w': nrm(ks[10], (DEPTH, SHORT_CONV, 3 * D_HYENA), SHORT_CONV ** -0.5),
        'hy_conv_b': nrm(ks[11], (DEPTH, 3 * D_HYENA), 0.02),
        'filt_w1': nrm(ks[12], (DEPTH, FILTER_EMB, FILTER_HIDDEN), FILTER_EMB ** -0.5),
        'filt_b1': nrm(ks[13], (DEPTH, FILTER_HIDDEN), 0.5),
        'filt_w2': nrm(ks[14], (DEPTH, FILTER_HIDDEN, FILTER_HIDDEN), FILTER_HIDDEN ** -0.5),
        'filt_b2': nrm(ks[15], (DEPTH, FILTER_HIDDEN), 0.5),
        'filt_w3': nrm(ks[16], (DEPTH, FILTER_HIDDEN, FILTER_HIDDEN), FILTER_HIDDEN ** -0.5),
        'filt_b3': nrm(ks[17], (DEPTH, FILTER_HIDDEN), 0.5),
        'filt_w4': nrm(ks[18], (DEPTH, FILTER_HIDDEN, HYENA_ORDER * 2 * D_HYENA), FILTER_GAIN * FILTER_HIDDEN ** -0.5),
        'filt_freq': gain(ks[19], FILTER_HIDDEN),
        'hy_bias': nrm(ks[20], (DEPTH, HYENA_ORDER, D_HYENA), 0.5),
        'w_hy_proj': nrm(ks[21], (DEPTH, D_HYENA, D_MODEL), D_HYENA ** -0.5),
        'w_att_proj': nrm(ks[22], (DEPTH, D_ATT_OUT, D_MODEL), D_ATT_OUT ** -0.5),
        'w_out': nrm(ks[23], (DEPTH, D_MODEL, D_MODEL), D_MODEL ** -0.5),
        'ffn2_pre_g': gain(ks[24], D_MODEL),
        'ffn2_post_g': gain(ks[25], D_MODEL),
        'ffn2_w_gate': nrm(ks[26], (DEPTH, D_MODEL, D_FF), D_MODEL ** -0.5),
        'ffn2_w_up': nrm(ks[27], (DEPTH, D_MODEL, D_FF), D_MODEL ** -0.5),
        'ffn2_w_down': nrm(ks[28], (DEPTH, D_FF, D_MODEL), D_FF ** -0.5),
    }


def reference(x_prompt, x_sample, ffn1_pre_g, ffn1_post_g, ffn1_w_gate, ffn1_w_up, ffn1_w_down,
              mix_pre_g, mix_post_g, w_in, hy_conv_w, hy_conv_b,
              filt_w1, filt_b1, filt_w2, filt_b2, filt_w3, filt_b3, filt_w4, filt_freq, hy_bias,
              w_hy_proj, w_att_proj, w_out,
              ffn2_pre_g, ffn2_post_g, ffn2_w_gate, ffn2_w_up, ffn2_w_down):
    params = (ffn1_pre_g, ffn1_post_g, ffn1_w_gate, ffn1_w_up, ffn1_w_down,
              mix_pre_g, mix_post_g, w_in, hy_conv_w, hy_conv_b,
              filt_w1, filt_b1, filt_w2, filt_b2, filt_w3, filt_b3, filt_w4, filt_freq, hy_bias,
              w_hy_proj, w_att_proj, w_out,
              ffn2_pre_g, ffn2_post_g, ffn2_w_gate, ffn2_w_up, ffn2_w_down)

    def run(x):
        for layer in range(DEPTH):
            x = encoder_layer(x, *[p[layer] for p in params])
        return x

    y_prompt = run(x_prompt)
    y_sample = run(x_sample)
    return (y_prompt, y_sample)
```

```cpp
#include <hip/hip_runtime.h>
#include <hip/hip_cooperative_groups.h>
#include <cstdio>
namespace cg = cooperative_groups;

#define LAS __attribute__((address_space(3)))
typedef unsigned short bf16_t;
typedef short bf16x8 __attribute__((ext_vector_type(8)));
typedef short bf16x4 __attribute__((ext_vector_type(4)));
typedef float f32x4 __attribute__((ext_vector_type(4)));
typedef unsigned u32x4 __attribute__((ext_vector_type(4)));
typedef unsigned u32x2 __attribute__((ext_vector_type(2)));

constexpr int DM = 2048, DFF = 5632, DHY = 1024, DATT = 1536, DAO = 512;
constexpr int LP = 16384, LSQ = 8192, MP = 2 * LP, MS = 2 * LSQ, MT = MP + MS;
constexpr size_t MiB = (size_t)1 << 20;
constexpr int LDS_BYTES = 150 * 1024;
constexpr int LDS_QSLOT = LDS_BYTES - 32;
constexpr size_t WS_WFFN = 0;
constexpr size_t WS_WD = 44 * MiB;
constexpr size_t WS_WINHQ = 0;
constexpr size_t WS_WGATES = 30 * MiB, WS_WHP = 46 * MiB, WS_WAP = 50 * MiB, WS_WOUT = 52 * MiB;
constexpr size_t WS_XN = 66 * MiB;
constexpr size_t WS_DELTA = 258 * MiB;
constexpr size_t WS_BIG = 450 * MiB;
constexpr size_t WS_V = 738 * MiB;
constexpr size_t WS_B = 786 * MiB;
constexpr size_t WS_SCR1 = 882 * MiB;
constexpr size_t WS_ROPE = 1010 * MiB;
constexpr size_t WS_H3T = 1012 * MiB;
constexpr size_t WS_BAR = 1018 * MiB;
constexpr size_t WS_QCNT = WS_BAR + 16384;
constexpr size_t WS_NEED = 1019 * MiB;
constexpr size_t DO_Q = 0, DO_K = 144 * MiB, DO_LSE = 288 * MiB, DO_Y = 291 * MiB, DO_HY = 144 * MiB, DO_MERGED = 0;

struct Params {
  const float* in[29];
  float* out;
  unsigned char* ws;
  int ph_lo, ph_hi;
};

__device__ __forceinline__ unsigned cvt_pk_bf16(float lo, float hi) { unsigned r; asm volatile("v_cvt_pk_bf16_f32 %0, %1, %2" : "=v"(r) : "v"(lo), "v"(hi)); return r; }
__device__ __forceinline__ bf16_t f2bf(float f) { return (bf16_t)(cvt_pk_bf16(f, 0.f) & 0xffffu); }
__device__ __forceinline__ float bf2f(bf16_t b) { return __uint_as_float(((unsigned)b) << 16); }
__device__ __forceinline__ float bflo(unsigned w) { return __uint_as_float(w << 16); }
__device__ __forceinline__ float bfhi(unsigned w) { return __uint_as_float(w & 0xffff0000u); }
__device__ __forceinline__ float wave_sum(float v) {
#pragma unroll
  for (int o = 32; o > 0; o >>= 1) v += __shfl_xor(v, o);
  return v;
}
__device__ __forceinline__ float sigmoidf_(float x) { return __builtin_amdgcn_rcpf(1.0f + __expf(-x)); }
__device__ __forceinline__ const float* xrow(const Params& p, int tok) { return tok < MP ? p.in[0] + (size_t)tok * DM : p.in[1] + (size_t)(tok - MP) * DM; }

namespace pg8 {
constexpr int BM = 256, BK = 64, HALF = 128, HTB = HALF * BK * 2, STAGE_BYTES = 8 * HTB, NXCD = 8, WGM = 8;
__device__ __forceinline__ int lds_byte(int r, int c) { const int st = (r >> 4) * 2 + (c >> 5), rr = r & 15, cc = c & 31, ob = rr * 64 + cc * 2; return st * 1024 + (ob ^ (((ob >> 9) & 1) << 5)); }
__device__ __forceinline__ void stage_rc(int b, int& R, int& C) { const int st = b / 1024, sb = b % 1024, swz = sb ^ (((sb >> 9) & 1) << 5); R = (st >> 1) * 16 + swz / 64; C = (st & 1) * 32 + (swz % 64) / 2; }
__device__ __forceinline__ int perm32(int rho) { const int n = rho >> 4, i = rho & 15; return 8 * (i >> 2) + 4 * n + (i & 3); }
struct Unit { int pm, pn; };
struct Gemm { const bf16_t* A; const bf16_t* Bt; int M, N, K; };
struct StaticOrder {
  static constexpr bool DYNAMIC = false;
  int nM, nN, nwg, G, c;
  __device__ void init(int M, int N, int G_, int c_) { nM = M / BM; nN = N / BM; nwg = nM * nN; G = G_; c = c_; }
  __device__ bool next(int i, Unit& u) const {
    const long L = (long)i * G + c; if (L >= nwg) return false;
    int wgid = (int)L; { const int q = nwg / NXCD, r = nwg % NXCD, xcd = wgid % NXCD, off = wgid / NXCD; wgid = (xcd < r ? xcd * (q + 1) : r * (q + 1) + (xcd - r) * q) + off; }
    const int nig = WGM * nN, gid = wgid / nig, fm = gid * WGM, gsz = (nM - fm) < WGM ? (nM - fm) : WGM;
    u.pm = fm + ((wgid % nig) % gsz); u.pn = (wgid % nig) / gsz; return true;
  }
};

struct DynOrder {
  static constexpr bool DYNAMIC = true;
  int nM, nN, nwg; unsigned* cnt; int xcc; volatile LAS int* slot;
  __device__ void init(int M, int N, unsigned* cnt_, int xcc_, volatile LAS int* slot_) { nM = M / BM; nN = N / BM; nwg = nM * nN; cnt = cnt_; xcc = xcc_ & (NXCD - 1); slot = slot_; }
  __device__ __forceinline__ unsigned issue() const { return __builtin_amdgcn_atomic_inc32(cnt + xcc * 16, 0xffffffffu, __ATOMIC_RELAXED, "agent"); }
  __device__ int resolve(unsigned off) const {
    const int q = nwg / NXCD, r = nwg % NXCD;
    { const int cy = q + (xcc < r ? 1 : 0), sy = (xcc < r) ? xcc * (q + 1) : r * (q + 1) + (xcc - r) * q; if ((int)off < cy) return sy + (int)off; }
    for (int s = 1; s < NXCD; ++s) {
      const int y = (xcc + s) & (NXCD - 1);
      const int cy = q + (y < r ? 1 : 0), sy = (y < r) ? y * (q + 1) : r * (q + 1) + (y - r) * q;
      const unsigned o2 = __hip_atomic_fetch_add(cnt + y * 16, 1u, __ATOMIC_RELAXED, __HIP_MEMORY_SCOPE_AGENT);
      if ((int)o2 < cy) return sy + (int)o2;
    }
    return -1;
  }
  __device__ void decode(int wgid, Unit& u) const {
    const int nig = WGM * nN, gid = wgid / nig, fm = gid * WGM, gsz = (nM - fm) < WGM ? (nM - fm) : WGM;
    u.pm = fm + ((wgid % nig) % gsz); u.pn = (wgid % nig) / gsz;
  }
};

template <class Epi, class Sched>
__device__ __forceinline__ void gemm_phase(LAS unsigned char* lds, const Gemm g, const Sched& S, const Epi& E) {
  int tid = threadIdx.x; asm volatile("" : "+v"(tid));
  const int wid = __builtin_amdgcn_readfirstlane(tid >> 6), lane = tid & 63, wr = wid >> 2, wc = wid & 3, fr = lane & 15, fq = lane >> 4;
  const int K = g.K, nt = K / BK;
  unsigned voffA[2], voffB[2];
#pragma unroll
  for (int i = 0; i < 2; ++i) { int R, C; stage_rc(tid * 16 + i * 8192, R, C); const int Rb = Epi::PERM ? ((R & ~31) + perm32(R & 31)) : R;
    voffA[i] = (unsigned)(R * K + C) * 2u; voffB[i] = (unsigned)(Rb * K + C) * 2u; }
  const size_t kstep = (size_t)(BK * 2);
  const size_t hstep = (size_t)HALF * K * 2;
  const size_t tstep = 2 * hstep;
  const unsigned ldsw = (unsigned)wid * 1024u;
  const int aoff = lds_byte(wr * 64 + fr, fq * 8), boff = lds_byte(wc * 32 + fr, fq * 8);
#define PG8_SA(b, h) (((b) * 2 + (h)) * HTB)
#define PG8_SB(b, h) ((4 + (b) * 2 + (h)) * HTB)
#define PG8_STAGE(bufoff, gbase, voff) do { _Pragma("unroll") for (int _i = 0; _i < 2; ++_i) \
    __builtin_amdgcn_global_load_lds((const unsigned*)((const char*)(gbase) + (voff)[_i]), (LAS unsigned*)(lds + (bufoff) + ldsw + _i * 8192), 16, 0, 0); } while (0)
#define PG8_LDA(dst, b, h) do { _Pragma("unroll") for (int m = 0; m < 4; ++m) _Pragma("unroll") for (int k = 0; k < 2; ++k) dst[m][k] = *(const LAS bf16x8*)(lds + PG8_SA(b, h) + aoff + m * 2048 + k * 1024); } while (0)
#define PG8_LDB(dst, b, h) do { _Pragma("unroll") for (int n = 0; n < 2; ++n) _Pragma("unroll") for (int k = 0; k < 2; ++k) dst[n][k] = *(const LAS bf16x8*)(lds + PG8_SB(b, h) + boff + n * 2048 + k * 1024); } while (0)
#define PG8_MMA(ai, bj, At, Bt) do { __builtin_amdgcn_s_setprio(1); _Pragma("unroll") for (int m = 0; m < 4; ++m) _Pragma("unroll") for (int n = 0; n < 2; ++n) _Pragma("unroll") for (int k = 0; k < 2; ++k) \
    acc[ai][bj][m][n] = __builtin_amdgcn_mfma_f32_16x16x32_bf16(Bt[n][k], At[m][k], acc[ai][bj][m][n], 0, 0, 0); __builtin_amdgcn_s_setprio(0); } while (0)
#define PG8_WAIT_V(n) asm volatile("s_waitcnt vmcnt(" #n ")" ::: "memory")
#define PG8_WAIT_L(n) asm volatile("s_waitcnt lgkmcnt(" #n ")" ::: "memory")
#define PG8_BAR __builtin_amdgcn_s_barrier()
#define PG8_SCHED __builtin_amdgcn_sched_barrier(0)
  Unit cur, nxt; int ui = 0; unsigned pend = 0u;
  if constexpr (Sched::DYNAMIC) {
    if (tid == 0) { const int a0 = S.resolve(S.issue()); pend = S.issue(); S.slot[0] = a0; }
    __syncthreads();
    const int w0 = __builtin_amdgcn_readfirstlane(S.slot[0]);
    if (w0 < 0) return;
    S.decode(w0, cur);
  } else { if (!S.next(0, cur)) return; }
  f32x4 acc[2][2][4][2];
#pragma unroll
  for (int a = 0; a < 2; ++a)
#pragma unroll
    for (int b = 0; b < 2; ++b)
#pragma unroll
      for (int m = 0; m < 4; ++m)
#pragma unroll
        for (int n = 0; n < 2; ++n) acc[a][b][m][n] = (f32x4){0.f, 0.f, 0.f, 0.f};
  bf16x8 At[4][2], B0[2][2], B1[2][2];
  const char* cA = (const char*)g.A + (size_t)cur.pm * tstep; const char* cB = (const char*)g.Bt + (size_t)cur.pn * tstep;
  PG8_STAGE(PG8_SB(0, 0), cB, voffB); PG8_STAGE(PG8_SA(0, 0), cA, voffA); PG8_STAGE(PG8_SB(0, 1), cB + hstep, voffB); PG8_STAGE(PG8_SA(0, 1), cA + hstep, voffA);
  if (wr == 1) PG8_BAR;
  PG8_WAIT_V(4); PG8_BAR;
  PG8_STAGE(PG8_SB(1, 0), cB + kstep, voffB); PG8_STAGE(PG8_SA(1, 0), cA + kstep, voffA); PG8_STAGE(PG8_SB(1, 1), cB + hstep + kstep, voffB);
  PG8_WAIT_V(6); PG8_BAR;
  for (;;) {
    bool has_next;
    if constexpr (Sched::DYNAMIC) {
      if (tid == 0) { S.slot[(ui + 1) & 1] = S.resolve(pend); pend = S.issue(); }
      asm volatile("s_waitcnt lgkmcnt(0)" ::: "memory"); PG8_BAR; asm volatile("" ::: "memory");
      const int w = __builtin_amdgcn_readfirstlane(S.slot[(ui + 1) & 1]);
      has_next = w >= 0; if (has_next) S.decode(w, nxt);
    } else has_next = S.next(ui + 1, nxt);
    const char* nA = has_next ? (const char*)g.A + (size_t)nxt.pm * tstep : cA; const char* nB = has_next ? (const char*)g.Bt + (size_t)nxt.pn * tstep : cB;
    for (int t = 0; t < nt; t += 2) {
      const bool last = (t == nt - 2);
      const char* a1 = cA + (size_t)(t + 1) * kstep;
      const char* a2 = last ? nA : cA + (size_t)(t + 2) * kstep; const char* b2 = last ? nB : cB + (size_t)(t + 2) * kstep;
      const char* a3 = a2 + kstep; const char* b3 = b2 + kstep;
      PG8_LDB(B0, 0, 0); PG8_SCHED; PG8_LDA(At, 0, 0); PG8_STAGE(PG8_SA(1, 1), a1 + hstep, voffA);
      PG8_WAIT_L(8); PG8_BAR; PG8_WAIT_L(0); PG8_MMA(0, 0, At, B0); PG8_BAR; PG8_SCHED;
      PG8_LDB(B1, 0, 1); PG8_STAGE(PG8_SB(0, 0), b2, voffB);
      PG8_BAR; PG8_WAIT_L(0); PG8_MMA(0, 1, At, B1); PG8_BAR;
      PG8_LDA(At, 0, 1); PG8_STAGE(PG8_SA(0, 0), a2, voffA);
      PG8_BAR; PG8_WAIT_L(0); PG8_MMA(1, 0, At, B0); PG8_BAR; PG8_SCHED;
      PG8_STAGE(PG8_SB(0, 1), b2 + hstep, voffB);
      PG8_WAIT_V(6); PG8_BAR; PG8_MMA(1, 1, At, B1); PG8_BAR;
      PG8_LDB(B0, 1, 0); PG8_SCHED; PG8_LDA(At, 1, 0); PG8_STAGE(PG8_SA(0, 1), a2 + hstep, voffA);
      PG8_WAIT_L(8); PG8_BAR; PG8_WAIT_L(0); PG8_MMA(0, 0, At, B0); PG8_BAR; PG8_SCHED;
      PG8_LDB(B1, 1, 1); PG8_STAGE(PG8_SB(1, 0), b3, voffB);
      PG8_BAR; PG8_WAIT_L(0); PG8_MMA(0, 1, At, B1); PG8_BAR;
      PG8_LDA(At, 1, 1); PG8_STAGE(PG8_SA(1, 0), a3, voffA);
      PG8_BAR; PG8_WAIT_L(0); PG8_MMA(1, 0, At, B0); PG8_BAR; PG8_SCHED;
      PG8_STAGE(PG8_SB(1, 1), b3 + hstep, voffB);
      PG8_WAIT_V(6); PG8_BAR; PG8_MMA(1, 1, At, B1); PG8_BAR;
    }
    E(acc, cur, wr, wc, fr, fq);
    if (!has_next) break;
#pragma unroll
    for (int a = 0; a < 2; ++a)
#pragma unroll
      for (int b = 0; b < 2; ++b)
#pragma unroll
        for (int m = 0; m < 4; ++m)
#pragma unroll
          for (int n = 0; n < 2; ++n) acc[a][b][m][n] = (f32x4){0.f, 0.f, 0.f, 0.f};
    cur = nxt; cA = nA; cB = nB; ++ui;
  }
  PG8_WAIT_V(0);
  if (wr == 0) PG8_BAR;
  PG8_BAR;
#undef PG8_SA
#undef PG8_SB
#undef PG8_STAGE
#undef PG8_LDA
#undef PG8_LDB
#undef PG8_MMA
#undef PG8_WAIT_V
#undef PG8_WAIT_L
#undef PG8_BAR
#undef PG8_SCHED
}

struct EpiF32 {
  static constexpr bool PERM = false;
  float* C; int ldc;
  __device__ __forceinline__ void operator()(const f32x4 (&acc)[2][2][4][2], const Unit& u, int wr, int wc, int fr, int fq) const {
    const int row0 = u.pm * BM + wr * 64 + fr, col0 = u.pn * BM + wc * 32 + 4 * fq;
#pragma unroll
    for (int ai = 0; ai < 2; ++ai)
#pragma unroll
      for (int m = 0; m < 4; ++m) { float* rowp = C + (size_t)(row0 + ai * HALF + m * 16) * ldc + col0;
#pragma unroll
        for (int bj = 0; bj < 2; ++bj)
#pragma unroll
          for (int n = 0; n < 2; ++n) *(f32x4*)(rowp + bj * HALF + n * 16) = acc[ai][bj][m][n]; }
  }
};
struct EpiBf16 {
  static constexpr bool PERM = true;
  bf16_t* O; int ldc;
  __device__ __forceinline__ void operator()(const f32x4 (&acc)[2][2][4][2], const Unit& u, int wr, int wc, int fr, int fq) const {
    const int row0 = u.pm * BM + wr * 64 + fr, col0 = u.pn * BM + wc * 32 + 8 * fq;
#pragma unroll
    for (int ai = 0; ai < 2; ++ai)
#pragma unroll
      for (int m = 0; m < 4; ++m) { bf16_t* rowp = O + (size_t)(row0 + ai * HALF + m * 16) * ldc + col0;
#pragma unroll
        for (int bj = 0; bj < 2; ++bj) { const f32x4 v0 = acc[ai][bj][m][0], v1 = acc[ai][bj][m][1];
          u32x4 w; w.x = cvt_pk_bf16(v0[0], v0[1]); w.y = cvt_pk_bf16(v0[2], v0[3]); w.z = cvt_pk_bf16(v1[0], v1[1]); w.w = cvt_pk_bf16(v1[2], v1[3]);
          *(u32x4*)(rowp + bj * HALF) = w; } }
  }
};
struct EpiTiled {
  static constexpr bool PERM = true;
  bf16_t* O;
  __device__ __forceinline__ void operator()(const f32x4 (&acc)[2][2][4][2], const Unit& u, int wr, int wc, int fr, int fq) const {
    const int wave = wr * 4 + wc, lane = fq * 16 + fr;
#pragma unroll
    for (int ai = 0; ai < 2; ++ai)
#pragma unroll
      for (int m = 0; m < 4; ++m)
#pragma unroll
        for (int bj = 0; bj < 2; ++bj) { const f32x4 v0 = acc[ai][bj][m][0], v1 = acc[ai][bj][m][1];
          u32x4 w; w.x = cvt_pk_bf16(v0[0], v0[1]); w.y = cvt_pk_bf16(v0[2], v0[3]); w.z = cvt_pk_bf16(v1[0], v1[1]); w.w = cvt_pk_bf16(v1[2], v1[3]);
          const size_t idx = ((((size_t)(u.pm * 16 + 2 * u.pn + bj) * 2 + ai) * 4 + m) * 8 + wave) * 64 + lane;
          *(u32x4*)(O + idx * 8) = w; }
  }
};
struct EpiSwiGLU {
  static constexpr bool PERM = true;
  bf16_t* H;
  __device__ __forceinline__ void operator()(const f32x4 (&acc)[2][2][4][2], const Unit& u, int wr, int wc, int fr, int fq) const {
    const int row0 = u.pm * BM + wr * 64 + fr, col0 = u.pn * HALF + wc * 32 + 8 * fq;
#pragma unroll
    for (int ai = 0; ai < 2; ++ai)
#pragma unroll
      for (int m = 0; m < 4; ++m) {
        float h[8];
#pragma unroll
        for (int n = 0; n < 2; ++n)
#pragma unroll
          for (int j = 0; j < 4; ++j) { const float gt = acc[ai][0][m][n][j], up = acc[ai][1][m][n][j]; h[n * 4 + j] = gt * sigmoidf_(gt) * up; }
        u32x4 w; w.x = cvt_pk_bf16(h[0], h[1]); w.y = cvt_pk_bf16(h[2], h[3]); w.z = cvt_pk_bf16(h[4], h[5]); w.w = cvt_pk_bf16(h[6], h[7]);
        *(u32x4*)(H + (size_t)(row0 + ai * HALF + m * 16) * DFF + col0) = w; }
  }
};
struct EpiInProj {
  static constexpr bool PERM = true;
  bf16_t* hyT; bf16_t* q; bf16_t* k; bf16_t* v; const float2* rope; LAS unsigned char* tl;
  __device__ __forceinline__ void operator()(const f32x4 (&acc)[2][2][4][2], const Unit& u, int wr, int wc, int fr, int fq) const {
    const int row0 = u.pm * BM + wr * 64 + fr;
    if (u.pn < 12) {
      const int tok0 = u.pm * BM; size_t base; int L, t0;
      if (tok0 < MP) { L = LP; const int s = tok0 >> 14; t0 = tok0 & (LP - 1); base = (size_t)s * 3072 * LP; }
      else { L = LSQ; const int tk = tok0 - MP, s = tk >> 13; t0 = tk & (LSQ - 1); base = (size_t)2 * 3072 * LP + (size_t)s * 3072 * LSQ; }
      const int wave = wr * 4 + wc, lane = fq * 16 + fr;
      LAS bf16_t* T = (LAS bf16_t*)(tl + wave * 2304);
      bf16_t* gp = hyT + base + t0 + wr * 64;
#pragma unroll
      for (int ai = 0; ai < 2; ++ai)
#pragma unroll
        for (int bj = 0; bj < 2; ++bj)
#pragma unroll
          for (int n = 0; n < 2; ++n) {
#pragma unroll
            for (int m = 0; m < 4; ++m)
#pragma unroll
              for (int j = 0; j < 4; ++j) T[(4 * fq + j) * 72 + 16 * m + fr] = f2bf(acc[ai][bj][m][n][j]);
#pragma unroll
            for (int rr = 0; rr < 2; ++rr) {
              const int chl = (lane >> 3) + 8 * rr, tloc = (lane & 7) * 8;
              const u32x4 w = *(const LAS u32x4*)(T + chl * 72 + tloc);
              const int cabs = u.pn * BM + bj * HALF + wc * 32 + 8 * (chl >> 2) + 4 * n + (chl & 3);
              *(u32x4*)(gp + (size_t)cabs * L + ai * HALF + tloc) = w;
            }
          }
    } else {
      const int cc = (u.pn - 12) * BM, which = cc / DATT, within = cc - which * DATT;
      bf16_t* O = (which == 2) ? v : (q + (size_t)which * ((DO_K - DO_Q) / 2));
      const int col0 = within + wc * 32 + 8 * fq;
      const bool do_rope = (which < 2) && (wc == 0);
      f32x4 cs[4], r16[4];
      if (do_rope) {
        const int pos0 = row0 < MP ? (row0 & (LP - 1)) : ((row0 - MP) & (LSQ - 1));
        const f32x4* tp = (const f32x4*)(rope + pos0 * 16 + 8 * (fq & 1));
        const f32x4* rp = (const f32x4*)(rope + 16 * 16 + 8 * (fq & 1));
#pragma unroll
        for (int e = 0; e < 4; ++e) { cs[e] = tp[e]; r16[e] = rp[e]; }
      }
#pragma unroll
      for (int ai = 0; ai < 2; ++ai)
#pragma unroll
        for (int m = 0; m < 4; ++m) {
          const int row = row0 + ai * HALF + m * 16;
          bf16_t* rowp = O + (size_t)row * DATT + col0;
#pragma unroll
          for (int bj = 0; bj < 2; ++bj) {
            f32x4 v0 = acc[ai][bj][m][0], v1 = acc[ai][bj][m][1];
            if (do_rope) {
#pragma unroll
              for (int e = 0; e < 4; ++e) {
                const float a = v0[e], b = v1[e];
                const float pa = __shfl_xor(a, 32), pb = __shfl_xor(b, 32);
                const float ca = cs[e >> 1][(e & 1) * 2], sa = cs[e >> 1][(e & 1) * 2 + 1], cb = cs[2 + (e >> 1)][(e & 1) * 2], sb = cs[2 + (e >> 1)][(e & 1) * 2 + 1];
                v0[e] = fq < 2 ? a * ca - pa * sa : a * ca + pa * sa;
                v1[e] = fq < 2 ? b * cb - pb * sb : b * cb + pb * sb;
              }
            }
            u32x4 w; w.x = cvt_pk_bf16(v0[0], v0[1]); w.y = cvt_pk_bf16(v0[2], v0[3]); w.z = cvt_pk_bf16(v1[0], v1[1]); w.w = cvt_pk_bf16(v1[2], v1[3]);
            *(u32x4*)(rowp + bj * HALF) = w; }
          if (do_rope) {
            const int steps = (m == 3) ? 5 : 1;
#pragma unroll
            for (int st = 0; st < steps; ++st)
#pragma unroll
              for (int e = 0; e < 4; ++e) {
                const f32x4 c = cs[e], r = r16[e];
                cs[e] = (f32x4){c[0] * r[0] - c[1] * r[1], c[0] * r[1] + c[1] * r[0], c[2] * r[2] - c[3] * r[3], c[2] * r[3] + c[3] * r[2]};
              }
          }
        }
    }
  }
};
struct EpiMerge {
  static constexpr bool PERM = true;
  const bf16_t* Aa; const bf16_t* Bb; bf16_t* O;
  __device__ __forceinline__ void operator()(const f32x4 (&acc)[2][2][4][2], const Unit& u, int wr, int wc, int fr, int fq) const {
    const int row0 = u.pm * BM + wr * 64 + fr, col0 = u.pn * HALF + wc * 32 + 8 * fq;
#pragma unroll
    for (int ai = 0; ai < 2; ++ai) {
      u32x4 av[4], bv[4];
      const int wave = wr * 4 + wc, lane = fq * 16 + fr;
#pragma unroll
      for (int m = 0; m < 4; ++m) { const size_t idx = ((((size_t)(u.pm * 16 + u.pn) * 2 + ai) * 4 + m) * 8 + wave) * 64 + lane; av[m] = *(const u32x4*)(Aa + idx * 8); bv[m] = *(const u32x4*)(Bb + idx * 8); }
#pragma unroll
      for (int m = 0; m < 4; ++m) {
        const size_t off = (size_t)(row0 + ai * HALF + m * 16) * DM + col0;
        float o[8];
#pragma unroll
        for (int n = 0; n < 2; ++n)
#pragma unroll
          for (int j = 0; j < 4; ++j) {
            const int e = n * 4 + j; const unsigned aw = av[m][e >> 1], bw = bv[m][e >> 1];
            const float a = (e & 1) ? bfhi(aw) : bflo(aw), b = (e & 1) ? bfhi(bw) : bflo(bw);
            o[e] = sigmoidf_(acc[ai][0][m][n][j]) * a + sigmoidf_(acc[ai][1][m][n][j]) * b; }
        u32x4 w; w.x = cvt_pk_bf16(o[0], o[1]); w.y = cvt_pk_bf16(o[2], o[3]); w.z = cvt_pk_bf16(o[4], o[5]); w.w = cvt_pk_bf16(o[6], o[7]);
        *(u32x4*)(O + off) = w; }
    }
  }
};
}

template <class Epi>
__device__ __forceinline__ void run_gemm(unsigned char* shm, const bf16_t* A, const bf16_t* Bt, int M, int N, int K, const Epi& E, unsigned* qcnt, int xcc) {
  pg8::Gemm g; g.A = A; g.Bt = Bt; g.M = M; g.N = N; g.K = K;
  pg8::DynOrder S; S.init(M, N, qcnt, xcc, (volatile LAS int*)(LAS unsigned char*)(shm + LDS_QSLOT));
  pg8::gemm_phase<Epi, pg8::DynOrder>((LAS unsigned char*)shm, g, S, E);
}

__device__ void convert_wt(unsigned char* shm, const float* W, int K, int ldw, int c0, int ncols, bf16_t* Bt, int blk, int off) {
  float* tile = (float*)shm;
  int tid = threadIdx.x; asm volatile("" : "+v"(tid));
  const int tk = K / 64, tn = ncols / 64, ntile = tk * tn;
  for (int t = blockIdx.x; t < ntile; t += gridDim.x) {
    const int kt = t % tk, nt_ = t / tk;
    __syncthreads();
#pragma unroll
    for (int i = 0; i < 8; ++i) { const int e = tid + i * 512, r = e >> 6, c = e & 63; tile[r * 65 + c] = W[(size_t)(kt * 64 + r) * ldw + c0 + nt_ * 64 + c]; }
    __syncthreads();
#pragma unroll
    for (int i = 0; i < 4; ++i) { const int e = tid + i * 512, n = e >> 5, kp = (e & 31) * 2; const int c = nt_ * 64 + n;
      const unsigned w = cvt_pk_bf16(tile[kp * 65 + n], tile[(kp + 1) * 65 + n]);
      *(unsigned*)(Bt + (size_t)((c >> 7) * blk + off + (c & 127)) * K + kt * 64 + kp) = w; }
  }
  __syncthreads();
}

template <int MODE>
__device__ void row_pass(const Params& p, const bf16_t* d, int ldd, const float* g0, const float* g1, bf16_t* xs, bf16_t* xn, float* out) {
  int tid = threadIdx.x; asm volatile("" : "+v"(tid));
  const int lane = tid & 63, wv = blockIdx.x * 8 + (tid >> 6), nw = gridDim.x * 8;
  for (int row = wv; row < MT; row += nw) {
    float xv[32];
    if (MODE <= 1) {
      const float* xr = xrow(p, row);
#pragma unroll
      for (int i = 0; i < 8; ++i) { const f32x4 t = *(const f32x4*)(xr + i * 256 + lane * 4); xv[i * 4] = t[0]; xv[i * 4 + 1] = t[1]; xv[i * 4 + 2] = t[2]; xv[i * 4 + 3] = t[3]; }
    } else {
#pragma unroll
      for (int i = 0; i < 8; ++i) { const u32x2 t = *(const u32x2*)(xs + (size_t)row * DM + i * 256 + lane * 4); xv[i * 4] = bflo(t.x); xv[i * 4 + 1] = bfhi(t.x); xv[i * 4 + 2] = bflo(t.y); xv[i * 4 + 3] = bfhi(t.y); }
    }
    if (MODE != 0) {
      float dv[32]; float ss = 0.f;
#pragma unroll
      for (int i = 0; i < 8; ++i) { const u32x2 t = *(const u32x2*)(d + (size_t)row * ldd + i * 256 + lane * 4);
        dv[i * 4] = bflo(t.x); dv[i * 4 + 1] = bfhi(t.x); dv[i * 4 + 2] = bflo(t.y); dv[i * 4 + 3] = bfhi(t.y);
        ss += dv[i * 4] * dv[i * 4] + dv[i * 4 + 1] * dv[i * 4 + 1] + dv[i * 4 + 2] * dv[i * 4 + 2] + dv[i * 4 + 3] * dv[i * 4 + 3]; }
      ss = wave_sum(ss);
      const float rs = rsqrtf(ss * (1.0f / DM) + 1e-6f) * (MODE == 2 ? 1.0f : 0.5f);
#pragma unroll
      for (int i = 0; i < 8; ++i) {
        const f32x4 gg = *(const f32x4*)(g0 + i * 256 + lane * 4);
        float r[4];
#pragma unroll
        for (int j = 0; j < 4; ++j) r[j] = xv[i * 4 + j] + dv[i * 4 + j] * rs * gg[j];
        if (MODE == 3) {
          *(f32x4*)(out + (size_t)row * DM + i * 256 + lane * 4) = (f32x4){r[0], r[1], r[2], r[3]};
        } else {
          const unsigned w0 = cvt_pk_bf16(r[0], r[1]), w1 = cvt_pk_bf16(r[2], r[3]);
          *(u32x2*)(xs + (size_t)row * DM + i * 256 + lane * 4) = (u32x2){w0, w1};
          xv[i * 4] = bflo(w0); xv[i * 4 + 1] = bfhi(w0); xv[i * 4 + 2] = bflo(w1); xv[i * 4 + 3] = bfhi(w1);
        }
      }
    }
    if (MODE != 3) {
      float ss = 0.f;
#pragma unroll
      for (int i = 0; i < 32; ++i) ss += xv[i] * xv[i];
      ss = wave_sum(ss);
      const float rs = rsqrtf(ss * (1.0f / DM) + 1e-6f);
      const float* gn = (MODE == 0) ? g0 : g1;
#pragma unroll
      for (int i = 0; i < 8; ++i) {
        const f32x4 gg = *(const f32x4*)(gn + i * 256 + lane * 4);
        const unsigned w0 = cvt_pk_bf16(xv[i * 4] * rs * gg[0], xv[i * 4 + 1] * rs * gg[1]), w1 = cvt_pk_bf16(xv[i * 4 + 2] * rs * gg[2], xv[i * 4 + 3] * rs * gg[3]);
        *(u32x2*)(xn + (size_t)row * DM + i * 256 + lane * 4) = (u32x2){w0, w1};
      }
    }
  }
}

__device__ void make_tables(const Params& p) {
  float2* rope = (float2*)(p.ws + WS_ROPE);
  int tid = threadIdx.x; asm volatile("" : "+v"(tid));
  const int gt = blockIdx.x * 512 + tid, gs = gridDim.x * 512;
  for (int e = gt; e < LP * 16; e += gs) {
    const int t = e >> 4, i = e & 15;
    const float inv = powf(500000.0f, -(float)i / 16.0f), ang = (float)t * inv;
    float s, c; sincosf(ang, &s, &c); rope[e] = make_float2(c, s);
  }
  float* h3T = (float*)(p.ws + WS_H3T);
  const float *fw1 = p.in[12], *fb1 = p.in[13], *fw2 = p.in[14], *fb2 = p.in[15], *fw3 = p.in[16], *fb3 = p.in[17], *freq = p.in[19];
  const int lane = tid & 63, wv = blockIdx.x * 8 + (tid >> 6), nw = gridDim.x * 8;
  for (int tt = wv; tt < LP + LSQ; tt += nw) {
    const int grp = tt < LP ? 0 : 1, L = grp ? LSQ : LP, n = tt - (grp ? LP : 0);
    const float tn = (float)n / (float)(L - 1), w = (6.283185307179586f / (float)L) * (float)n;
    float z = 0.f;
    if (lane == 0) z = tn;
    else if (lane <= 32) { const int b = (lane - 1) & 15; const float f = 1e-4f + (float)b * ((15.0f - 1e-4f) / 15.0f); z = lane <= 16 ? cosf(f * w) : -sinf(f * w); }
    const float fr = freq[lane];
    float a = fb1[lane];
    for (int i = 0; i < 33; ++i) a += __shfl(z, i) * fw1[i * 64 + lane];
    float h = sinf(fr * a);
    a = fb2[lane];
    for (int i = 0; i < 64; ++i) a += __shfl(h, i) * fw2[i * 64 + lane];
    h = sinf(fr * a);
    a = fb3[lane];
    for (int i = 0; i < 64; ++i) a += __shfl(h, i) * fw3[i * 64 + lane];
    h = sinf(fr * a);
    h3T[(grp ? (size_t)64 * LP : 0) + (size_t)lane * L + n] = h;
  }
}

__device__ __forceinline__ int phys(int i) { return i + (i >> 5); }
__device__ __forceinline__ float2 cmul(float2 a, float2 b) { return make_float2(a.x * b.x - a.y * b.y, a.x * b.y + a.y * b.x); }
__device__ __forceinline__ float2 cmulc(float2 a, float2 b) { return make_float2(a.x * b.x + a.y * b.y, a.y * b.x - a.x * b.y); }
typedef float c32 __attribute__((ext_vector_type(2)));
__device__ __forceinline__ c32 cmul_pk(c32 a, c32 b) {
  c32 t, r;
  asm("v_pk_mul_f32 %0, %1, %2 op_sel:[0,0] op_sel_hi:[0,1]" : "=v"(t) : "v"(a), "v"(b));
  asm("v_pk_fma_f32 %0, %1, %2, %3 op_sel:[1,1,0] op_sel_hi:[1,0,1] neg_lo:[0,1,0]" : "=v"(r) : "v"(a), "v"(b), "v"(t));
  return r;
}
__device__ __forceinline__ float2 twid(float turns) { return make_float2(__builtin_amdgcn_cosf(turns), -__builtin_amdgcn_sinf(turns)); }

template <int R, bool INV>
__device__ __forceinline__ void butterflies(c32 (&v)[1 << R], float turns0) {
  constexpr int RAD = 1 << R;
  constexpr float TC[16] = {1.0f, 0.98078528040f, 0.92387953251f, 0.83146961230f, 0.70710678119f, 0.55557023302f, 0.38268343237f, 0.19509032202f,
                            0.0f, -0.19509032202f, -0.38268343237f, -0.55557023302f, -0.70710678119f, -0.83146961230f, -0.92387953251f, -0.98078528040f};
  constexpr float TS[16] = {0.0f, 0.19509032202f, 0.38268343237f, 0.55557023302f, 0.70710678119f, 0.83146961230f, 0.92387953251f, 0.98078528040f,
                            1.0f, 0.98078528040f, 0.92387953251f, 0.83146961230f, 0.70710678119f, 0.55557023302f, 0.38268343237f, 0.19509032202f};
  float2 tbs[R];
  tbs[0] = twid(turns0);
  if (INV) tbs[0].y = -tbs[0].y;
#pragma unroll
  for (int k = 1; k < R; ++k) tbs[k] = cmul(tbs[k - 1], tbs[k - 1]);
#pragma unroll
  for (int kk = 0; kk < R; ++kk) {
    const int k = INV ? (R - 1 - kk) : kk;
    const int hd = RAD >> (k + 1);
#pragma unroll
    for (int j = 0; j < RAD; ++j) {
      if ((j & hd) == 0) {
        const int m = (j & (hd - 1)) * (16 / hd);
        const float2 c = make_float2(TC[m], INV ? TS[m] : -TS[m]);
        const float2 twf = cmul(tbs[k], c);
        const c32 tw = {twf.x, twf.y};
        const c32 a = v[j], b = v[j + hd];
        if (!INV) { v[j] = a + b; v[j + hd] = cmul_pk(a - b, tw); }
        else { const c32 bt = cmul_pk(b, tw); v[j] = a + bt; v[j + hd] = a - bt; }
      }
    }
  }
}
__device__ __forceinline__ float2 unpk2(unsigned w) { return make_float2(bflo(w), bfhi(w)); }
struct NoLd {};
struct NoF { typedef NoLd Ld; __device__ __forceinline__ float2 operator()(int) const { return make_float2(0.f, 0.f); } __device__ __forceinline__ NoLd load(int) const { return NoLd(); } __device__ __forceinline__ void store(int, float2, const NoLd&) const {} };
template <int LOGN, int R, int DLOG, bool INV, int MODE, class F>
__device__ __forceinline__ void fft_pass(float2* X, const F& f) {
  constexpr int RAD = 1 << R, N = 1 << LOGN, dmin = 1 << DLOG, NGR = N >> R;
  constexpr int PSTEP = (DLOG >= 5) ? ((1 << DLOG) + (1 << (DLOG >= 5 ? DLOG - 5 : 0))) : 0;
  int tid0 = threadIdx.x; asm volatile("" : "+v"(tid0));
  c32* Xc = (c32*)X;
  auto gbase = [&](int g) { const int lo = g & (dmin - 1), hi = g >> DLOG; return (hi << (DLOG + R)) + lo; };
  auto fetch = [&](int g, c32 (&dst)[RAD]) {
    const int base = gbase(g);
#pragma unroll
    for (int j = 0; j < RAD; ++j) { if constexpr (MODE == 1) { const float2 sv = f(base + (j << DLOG)); dst[j] = (c32){sv.x, sv.y}; } }
  };
  c32 nxt[RAD];
  if constexpr (MODE == 1) fetch(tid0, nxt);
#pragma unroll 1
  for (int g = tid0; g < NGR; g += 512) {
    const int lo = g & (dmin - 1), base = gbase(g), pb = phys(base);
    c32 v[RAD];
    if constexpr (MODE == 1) {
#pragma unroll
      for (int j = 0; j < RAD; ++j) v[j] = nxt[j];
      if (g + 512 < NGR) fetch(g + 512, nxt);
    } else {
#pragma unroll
      for (int j = 0; j < RAD; ++j) v[j] = Xc[(DLOG >= 5) ? pb + j * PSTEP : phys(base + (j << DLOG))];
    }
    butterflies<R, INV>(v, (float)lo / (float)(RAD << DLOG));
    if constexpr (MODE == 2) {
      typename F::Ld ld[2][4];
#pragma unroll
      for (int j = 0; j < 4; ++j) ld[0][j] = f.load(base + (j << DLOG));
#pragma unroll
      for (int j0 = 0; j0 < RAD; j0 += 4) {
        constexpr int dummy = 0; (void)dummy;
        const int cur = (j0 >> 2) & 1;
        if (j0 + 4 < RAD) {
#pragma unroll
          for (int j = 0; j < 4; ++j) ld[cur ^ 1][j] = f.load(base + ((j0 + 4 + j) << DLOG));
        }
#pragma unroll
        for (int j = 0; j < 4; ++j) f.store(base + ((j0 + j) << DLOG), make_float2(v[j0 + j].x, v[j0 + j].y), ld[cur][j]);
      }
    } else {
#pragma unroll
      for (int j = 0; j < RAD; ++j) Xc[(DLOG >= 5) ? pb + j * PSTEP : phys(base + (j << DLOG))] = v[j];
    }
  }
  __syncthreads();
}
template <int LOGN>
__device__ __forceinline__ void fft_last_to_regs(const float2* X, c32 (&kf)[32]) {
  static_assert(LOGN == 14, "one radix-32 group per thread");
  const c32* Xc = (const c32*)X;
  int tid0 = threadIdx.x; asm volatile("" : "+v"(tid0));
  const int pb = tid0 * 33;
  c32 v[32];
#pragma unroll
  for (int j = 0; j < 32; ++j) v[j] = Xc[pb + j];
  butterflies<5, false>(v, 0.f);
#pragma unroll
  for (int j = 0; j < 32; ++j) kf[j] = v[j];
  __syncthreads();
}
template <int LOGN>
__device__ __forceinline__ void fft_fused_mul(float2* X, const c32 (&kf)[32]) {
  static_assert(LOGN == 14, "one radix-32 group per thread");
  c32* Xc = (c32*)X;
  int tid0 = threadIdx.x; asm volatile("" : "+v"(tid0));
  const int pb = tid0 * 33;
  c32 v[32];
#pragma unroll
  for (int j = 0; j < 32; ++j) v[j] = Xc[pb + j];
  butterflies<5, false>(v, 0.f);
#pragma unroll
  for (int j = 0; j < 32; ++j) v[j] = cmul_pk(v[j], kf[j]);
  butterflies<5, true>(v, 0.f);
#pragma unroll
  for (int j = 0; j < 32; ++j) Xc[pb + j] = v[j];
  __syncthreads();
}
__device__ __forceinline__ float sconv(const bf16_t* row, int t, int L, float w0, float w1, float w2, float b) {
  const int tm = t > 0 ? t - 1 : 0, tp = t + 1 < L ? t + 1 : L - 1;
  const float vm = bf2f(row[tm]), p0 = bf2f(row[t]), vp = bf2f(row[tp]);
  const float pm = t > 0 ? vm : 0.f, pp = t + 1 < L ? vp : 0.f;
  return pm * w0 + p0 * w1 + pp * w2 + b;
}
struct FiltSrc {
  typedef NoLd Ld;
  const bf16_t* hf; const bf16_t* hb; int L; int lshift; int chstride; int half; float invTurn;
  __device__ __forceinline__ float2 operator()(int i) const {
    const int ch = i >> lshift, t = i & (L - 1);
    const float f = bf2f(hf[ch * chstride + t]), bw = bf2f(hb[ch * chstride + (t > 0 ? L - t : 0)]);
    const float bwm = t > 0 ? bw : 0.f;
    if (half == 0) return make_float2(f + bwm, 0.f);
    const float2 tw = twid((float)t * invTurn); const float d = f - bwm; return make_float2(d * tw.x, d * tw.y);
  }
};
struct DataSrc {
  typedef NoLd Ld;
  const unsigned* Wd; int L; int half; float invTurn;
  __device__ __forceinline__ float2 operator()(int i) const { const float2 wv = unpk2(Wd[i]); return half ? cmul(wv, twid((float)(i & (L - 1)) * invTurn)) : wv; }
};
struct YSink { typedef NoLd Ld; unsigned* Yd; float sc; __device__ __forceinline__ NoLd load(int) const { return NoLd(); } __device__ __forceinline__ void store(int i, float2 v, const NoLd&) const { Yd[i] = cvt_pk_bf16(v.x * sc, v.y * sc); } };
struct GateLd { float2 e, wv; float s0, s1; };
struct GateSink {
  typedef GateLd Ld;
  const unsigned* Yd; unsigned* Wd; const bf16_t* gr0; const bf16_t* gr1; bf16_t* o0; bf16_t* o1; int L; int lshift; int rowdiff; int last;
  float invTurn, inv2L; float bias[2], g0[2], g1[2], g2[2], gb[2];
  __device__ __forceinline__ GateLd load(int i) const {
    const int ch = i >> lshift, t = i & (L - 1);
    const float a0 = ch ? g0[1] : g0[0], a1 = ch ? g1[1] : g1[0], a2 = ch ? g2[1] : g2[0], ab = ch ? gb[1] : gb[0];
    GateLd r; r.e = unpk2(Yd[i]); r.wv = unpk2(Wd[i]); r.s0 = sconv(gr0 + (size_t)ch * rowdiff, t, L, a0, a1, a2, ab); r.s1 = sconv(gr1 + (size_t)ch * rowdiff, t, L, a0, a1, a2, ab); return r;
  }
  __device__ __forceinline__ void store(int i, float2 v, const GateLd& r) const {
    const int ch = i >> lshift, t = i & (L - 1);
    const float bs = ch ? bias[1] : bias[0];
    const float2 o = cmulc(v, twid((float)t * invTurn));
    const float y0 = r.s0 * (r.e.x + o.x * inv2L + bs * r.wv.x), y1 = r.s1 * (r.e.y + o.y * inv2L + bs * r.wv.y);
    if (!last) Wd[i] = cvt_pk_bf16(y0, y1);
    else { o0[(size_t)ch * rowdiff + t] = f2bf(y0); o1[(size_t)ch * rowdiff + t] = f2bf(y1); }
  }
};
template <int LOGN, bool DUAL, bool INV, int MODE, class F>
__device__ __forceinline__ void fft_outer(float2* X, const F& f) {
  if constexpr (DUAL) fft_pass<LOGN + 1, 3, LOGN - 3, INV, MODE, F>(X, f);
  else fft_pass<LOGN, 4, LOGN - 4, INV, MODE, F>(X, f);
}
template <int LOGN, bool INV>
__device__ __forceinline__ void fft_mid(float2* X) {
  static_assert(LOGN == 14, "pass structure 4|3 + 5 + 5");
  NoF nf;
  fft_pass<14, 5, 5, INV, 0, NoF>(X, nf);
}
constexpr size_t DO_W = 323 * MiB;
template <int LOGN>
__device__ void hyena_filters(const Params& p, unsigned char* shm, int c0, int cstride) {
  constexpr int L = 1 << LOGN, grp = (LOGN == 13);
  int tid = threadIdx.x; asm volatile("" : "+v"(tid));
  float* sW = (float*)(shm + 135168);
  const float* __restrict__ h3T = (const float*)(p.ws + WS_H3T) + (grp ? (size_t)64 * LP : 0);
  bf16_t* FSb = (bf16_t*)(p.ws + WS_SCR1 + (size_t)blockIdx.x * (512 * 1024));
  const float* fw4 = p.in[18];
  __syncthreads();
  for (int e = tid; e < 1024; e += 512) { const int j = e >> 4, a = e & 15, k = a >> 2, f = a & 3; int c = c0 + k * cstride; if (c > 1023) c = 1023; sW[e] = fw4[(size_t)j * 4096 + f * 1024 + c]; }
  __syncthreads();
  const float dmin_ = -3.0701134573253944f, dmax_ = -15.350567286626973f;
  const float invL1 = 1.0f / (float)(L - 1);
#pragma unroll 1
  for (int t4 = tid * 4; t4 < L; t4 += 2048) {
    f32x4 acc[16];
#pragma unroll
    for (int a = 0; a < 16; ++a) acc[a] = (f32x4){0.f, 0.f, 0.f, 0.f};
#pragma unroll 1
    for (int j0 = 0; j0 < 64; j0 += 8) {
      f32x4 hv[8];
#pragma unroll
      for (int j = 0; j < 8; ++j) hv[j] = *(const f32x4*)(h3T + (size_t)(j0 + j) * L + t4);
#pragma unroll
      for (int j = 0; j < 8; ++j) {
        const f32x4* wp = (const f32x4*)(sW + (j0 + j) * 16);
#pragma unroll
        for (int q = 0; q < 4; ++q) { const f32x4 w = wp[q]; acc[q * 4] += hv[j] * w[0]; acc[q * 4 + 1] += hv[j] * w[1]; acc[q * 4 + 2] += hv[j] * w[2]; acc[q * 4 + 3] += hv[j] * w[3]; }
      }
    }
#pragma unroll
    for (int k = 0; k < 4; ++k) {
      int c = c0 + k * cstride; if (c > 1023) c = 1023;
      const float delta = fabsf(dmin_ + (float)c * ((dmax_ - dmin_) / 1023.0f));
      f32x4 dec;
#pragma unroll
      for (int e = 0; e < 4; ++e) dec[e] = __expf(-(float)(t4 + e) * invL1 * delta);
#pragma unroll
      for (int f = 0; f < 4; ++f) { const f32x4 v = acc[k * 4 + f] * dec; *(u32x2*)(FSb + (size_t)(k * 4 + f) * L + t4) = (u32x2){cvt_pk_bf16(v[0], v[1]), cvt_pk_bf16(v[2], v[3])}; }
    }
  }
  __syncthreads();
}
template <int LOGN, bool DUAL>
__device__ void hyena_unit(const Params& p, unsigned char* shm, int ca, int cb, int ka, int kb) {
  constexpr int L = 1 << LOGN, grp = (LOGN == 13), LOGX = DUAL ? LOGN + 1 : LOGN, LX = 1 << LOGX;
  int tid = threadIdx.x; asm volatile("" : "+v"(tid));
  float2* X = (float2*)shm;
  bf16_t* hyT = (bf16_t*)(p.ws + WS_BIG) + (grp ? (size_t)2 * 3072 * LP : 0);
  const size_t seqstride = (size_t)3072 * L;
  const bf16_t* FS = (const bf16_t*)(p.ws + WS_SCR1 + (size_t)blockIdx.x * (512 * 1024)) + (size_t)ka * 4 * L;
  const int chstride = (kb - ka) * 4 * L, rowdiff = (cb - ca) * L;
  unsigned* Wd = (unsigned*)((unsigned char*)p.out + DO_W + (size_t)blockIdx.x * (128 * 1024));
  unsigned* Yd = (unsigned*)((unsigned char*)p.out + DO_Y + (size_t)blockIdx.x * (128 * 1024));
  const float *cw = p.in[10], *cb_ = p.in[11], *hbias = p.in[20];
  __syncthreads();
  {
    const float w0a = cw[ca], w1a = cw[3072 + ca], w2a = cw[6144 + ca], bba = cb_[ca];
    const float w0b = cw[cb], w1b = cw[3072 + cb], w2b = cw[6144 + cb], bbb = cb_[cb];
    const bf16_t* r0 = hyT + (size_t)ca * L; const bf16_t* r1 = r0 + seqstride;
#pragma unroll 4
    for (int i = tid; i < LX; i += 512) {
      const int ch = i >> LOGN, t = i & (L - 1);
      const float w0 = ch ? w0b : w0a, w1 = ch ? w1b : w1a, w2 = ch ? w2b : w2a, bb = ch ? bbb : bba;
      Wd[i] = cvt_pk_bf16(sconv(r0 + (size_t)ch * rowdiff, t, L, w0, w1, w2, bb), sconv(r1 + (size_t)ch * rowdiff, t, L, w0, w1, w2, bb));
    }
  }
  __syncthreads();
  const float inv2L = 1.0f / (float)(2 * L), invTurn = 1.0f / (float)(2 * L);
#pragma unroll 1
  for (int n = 0; n < 2; ++n) {
    const int gca = (n + 1) * 1024 + ca, gcb = (n + 1) * 1024 + cb;
    GateSink gs; gs.Yd = Yd; gs.Wd = Wd; gs.gr0 = hyT + (size_t)gca * L; gs.gr1 = gs.gr0 + seqstride; gs.o0 = hyT + (size_t)ca * L; gs.o1 = gs.o0 + seqstride;
    gs.L = L; gs.lshift = LOGN; gs.rowdiff = rowdiff; gs.last = n; gs.invTurn = invTurn; gs.inv2L = inv2L;
    gs.bias[0] = hbias[n * 1024 + ca]; gs.bias[1] = hbias[n * 1024 + cb];
    gs.g0[0] = cw[gca]; gs.g1[0] = cw[3072 + gca]; gs.g2[0] = cw[6144 + gca]; gs.gb[0] = cb_[gca];
    gs.g0[1] = cw[gcb]; gs.g1[1] = cw[3072 + gcb]; gs.g2[1] = cw[6144 + gcb]; gs.gb[1] = cb_[gcb];
#pragma unroll 1
    for (int half = 0; half < 2; ++half) {
      c32 kf[32];
      FiltSrc fs; fs.hf = FS + (size_t)(2 * n) * L; fs.hb = fs.hf + L; fs.L = L; fs.lshift = LOGN; fs.chstride = chstride; fs.half = half; fs.invTurn = invTurn;
      fft_outer<LOGN, DUAL, false, 1>(X, fs);
      fft_mid<LOGX, false>(X);
      fft_last_to_regs<LOGX>(X, kf);
      DataSrc ds; ds.Wd = Wd; ds.L = L; ds.half = half; ds.invTurn = invTurn;
      fft_outer<LOGN, DUAL, false, 1>(X, ds);
      fft_mid<LOGX, false>(X);
      fft_fused_mul<LOGX>(X, kf);
      fft_mid<LOGX, true>(X);
      if (half == 0) { YSink ys; ys.Yd = Yd; ys.sc = inv2L; fft_outer<LOGN, DUAL, true, 2>(X, ys); }
      else fft_outer<LOGN, DUAL, true, 2>(X, gs);
    }
  }
}

constexpr int KP = 136, VP = 200;
struct AttItem { int tokbase, Ls, hc, dil, r, nb, gh; };
__device__ __forceinline__ AttItem att_decode(int it) {
  int seq, rem, L, tokbase;
  if (it < 6144) { seq = it / 3072; rem = it - seq * 3072; L = LP; tokbase = seq * LP; }
  else { const int i2 = it - 6144; seq = i2 / 1536; rem = i2 - seq * 1536; L = LSQ; tokbase = MP + seq * LSQ; }
  const int nblk = L / 64, hd = rem / nblk, blk = rem - hd * nblk, g = hd >> 2, h = hd & 3;
  const int dil = g == 0 ? 1 : (g == 1 ? 4 : 16), nbn = nblk / dil, r = blk / nbn, nb = blk - r * nbn;
  AttItem a; a.tokbase = tokbase; a.Ls = L / dil; a.hc = g * 512 + h * 128; a.dil = dil; a.r = r; a.nb = nb; a.gh = g * 4 + h; return a;
}
__device__ __forceinline__ void att_load(const Params& p, const AttItem& a, int tid, u32x4 (&kq)[8], u32x4 (&vv)[6]) {
  const bf16_t* qg = (const bf16_t*)((unsigned char*)p.out + DO_Q);
  const bf16_t* kg = (const bf16_t*)((unsigned char*)p.out + DO_K);
  const bf16_t* vg = (const bf16_t*)(p.ws + WS_V);
  const int s0 = (a.nb - 1) * 64;
#pragma unroll
  for (int i = 0; i < 8; ++i) {
    const int e = tid + i * 512, row = e >> 4, ch = e & 15;
    u32x4 val = {0u, 0u, 0u, 0u};
    if (row < 192) { const int s = s0 + row; if (s >= 0 && s < a.Ls) val = *(const u32x4*)(kg + (size_t)(a.tokbase + s * a.dil + a.r) * DATT + a.hc + ch * 8); }
    else val = *(const u32x4*)(qg + (size_t)(a.tokbase + (a.nb * 64 + row - 192) * a.dil + a.r) * DATT + a.hc + ch * 8);
    kq[i] = val;
  }
#pragma unroll
  for (int i = 0; i < 6; ++i) {
    const int e = tid + i * 512, ch = e / 192, row = e - ch * 192, s = s0 + row;
    u32x4 val = {0u, 0u, 0u, 0u};
    if (s >= 0 && s < a.Ls) val = *(const u32x4*)(vg + (size_t)(a.tokbase + s * a.dil + a.r) * DATT + a.hc + ch * 8);
    vv[i] = val;
  }
}
__device__ void attention_phase(const Params& p, unsigned char* shm) {
  int tid = threadIdx.x; asm volatile("" : "+v"(tid));
  const int lane = tid & 63, wid = tid >> 6, fr = lane & 15, fq = lane >> 4;
  bf16_t* Ks = (bf16_t*)shm;
  bf16_t* Qs = Ks + 192 * KP;
  bf16_t* Vt = Qs + 64 * KP;
  bf16_t* qg = (bf16_t*)((unsigned char*)p.out + DO_Q);
  float* lse = (float*)((unsigned char*)p.out + DO_LSE);
  u32x4 kq[8], vv[6];
  int it = blockIdx.x;
  if (it >= 9216) return;
  AttItem a = att_decode(it);
  att_load(p, a, tid, kq, vv);
#pragma unroll 1
  for (;;) {
    __syncthreads();
#pragma unroll
    for (int i = 0; i < 8; ++i) { const int e = tid + i * 512, row = e >> 4, ch = e & 15; *(u32x4*)(Ks + row * KP + ch * 8) = kq[i]; }
#pragma unroll
    for (int i = 0; i < 6; ++i) {
      const int e = tid + i * 512, ch = e / 192, row = e - ch * 192;
#pragma unroll
      for (int j = 0; j < 4; ++j) { Vt[(ch * 8 + 2 * j) * VP + row] = (bf16_t)(vv[i][j] & 0xffffu); Vt[(ch * 8 + 2 * j + 1) * VP + row] = (bf16_t)(vv[i][j] >> 16); }
    }
    __syncthreads();
    const AttItem cur = a;
    const int itn = it + gridDim.x;
    const bool has_next = itn < 9216;
    if (has_next) { a = att_decode(itn); att_load(p, a, tid, kq, vv); }
    const int qt = __builtin_amdgcn_readfirstlane(wid & 3), dh = __builtin_amdgcn_readfirstlane(wid >> 2), s0 = (cur.nb - 1) * 64;
    bf16x8 qf[4];
#pragma unroll
    for (int ks = 0; ks < 4; ++ks) qf[ks] = *(const bf16x8*)(Qs + (qt * 16 + fr) * KP + ks * 32 + fq * 8);
    f32x4 sc[12];
#pragma unroll
    for (int kt = 0; kt < 12; ++kt) {
      f32x4 acc = {0.f, 0.f, 0.f, 0.f};
      if (kt >= qt && kt <= qt + 8) {
#pragma unroll
        for (int ks = 0; ks < 4; ++ks) { const bf16x8 kf = *(const bf16x8*)(Ks + (kt * 16 + fr) * KP + ks * 32 + fq * 8); acc = __builtin_amdgcn_mfma_f32_16x16x32_bf16(kf, qf[ks], acc, 0, 0, 0); }
      }
      sc[kt] = acc;
    }
    const int qi = qt * 16 + fr;
    const float scale = 0.08838834764831845f;
    float mx = -3.0e38f;
#pragma unroll
    for (int kt = 0; kt < 12; ++kt)
#pragma unroll
      for (int j = 0; j < 4; ++j) {
        const int kk = kt * 16 + fq * 4 + j, s = s0 + kk;
        const bool ok = (kk >= qi) && (kk <= qi + 128) && (s >= 0) && (s < cur.Ls);
        const float v = ok ? sc[kt][j] * scale : -1e30f;
        sc[kt][j] = v; mx = fmaxf(mx, v);
      }
    mx = fmaxf(mx, __shfl_xor(mx, 16)); mx = fmaxf(mx, __shfl_xor(mx, 32));
    float sum = 0.f;
#pragma unroll
    for (int kt = 0; kt < 12; ++kt)
#pragma unroll
      for (int j = 0; j < 4; ++j) { const float pv = __expf(sc[kt][j] - mx); sc[kt][j] = pv; sum += pv; }
    sum += __shfl_xor(sum, 16); sum += __shfl_xor(sum, 32);
    const float inv = 1.0f / sum;
    f32x4 oacc[4];
#pragma unroll
    for (int dt = 0; dt < 4; ++dt) oacc[dt] = (f32x4){0.f, 0.f, 0.f, 0.f};
#pragma unroll
    for (int kb = 0; kb < 6; ++kb) {
      u32x4 pw; pw.x = cvt_pk_bf16(sc[2 * kb][0], sc[2 * kb][1]); pw.y = cvt_pk_bf16(sc[2 * kb][2], sc[2 * kb][3]); pw.z = cvt_pk_bf16(sc[2 * kb + 1][0], sc[2 * kb + 1][1]); pw.w = cvt_pk_bf16(sc[2 * kb + 1][2], sc[2 * kb + 1][3]);
      const bf16x8 pf = __builtin_bit_cast(bf16x8, pw);
#pragma unroll
      for (int dt = 0; dt < 4; ++dt) {
        const bf16_t* vr = Vt + (dh * 64 + dt * 16 + fr) * VP + kb * 32 + fq * 4;
        const u32x2 lo = *(const u32x2*)vr, hi = *(const u32x2*)(vr + 16);
        const u32x4 vw = {lo.x, lo.y, hi.x, hi.y};
        oacc[dt] = __builtin_amdgcn_mfma_f32_16x16x32_bf16(__builtin_bit_cast(bf16x8, vw), pf, oacc[dt], 0, 0, 0);
      }
    }
    const size_t tok = (size_t)(cur.tokbase + (cur.nb * 64 + qi) * cur.dil + cur.r);
#pragma unroll
    for (int dt = 0; dt < 4; ++dt) {
      const unsigned w0 = cvt_pk_bf16(oacc[dt][0] * inv, oacc[dt][1] * inv), w1 = cvt_pk_bf16(oacc[dt][2] * inv, oacc[dt][3] * inv);
      *(u32x2*)(qg + tok * DATT + cur.hc + dh * 64 + dt * 16 + fq * 4) = (u32x2){w0, w1};
    }
    if (dh == 0 && fq == 0) lse[tok * 12 + cur.gh] = mx + __logf(sum);
    if (!has_next) break;
    it = itn;
  }
  __syncthreads();
}

__device__ void transpose_hy(const Params& p, unsigned char* shm) {
  bf16_t* tile = (bf16_t*)shm;
  const bf16_t* hyT = (const bf16_t*)(p.ws + WS_BIG);
  bf16_t* hy = (bf16_t*)((unsigned char*)p.out + DO_HY);
  int tid = threadIdx.x; asm volatile("" : "+v"(tid));
  const int ntile = (MT / 64) * 16;
  for (int t = blockIdx.x; t < ntile; t += gridDim.x) {
    const int ct = t & 15, tt = t >> 4, tok0 = tt * 64;
    const bf16_t* src; int L;
    if (tok0 < MP) { L = LP; src = hyT + (size_t)(tok0 >> 14) * 3072 * LP + (tok0 & (LP - 1)); }
    else { L = LSQ; const int tk = tok0 - MP; src = hyT + (size_t)2 * 3072 * LP + (size_t)(tk >> 13) * 3072 * LSQ + (tk & (LSQ - 1)); }
    __syncthreads();
#pragma unroll
    for (int i = 0; i < 4; ++i) { const int e = tid + i * 512, cr = e >> 5, tp = (e & 31) * 2; *(unsigned*)(tile + cr * 66 + tp) = *(const unsigned*)(src + (size_t)(ct * 64 + cr) * L + tp); }
    __syncthreads();
#pragma unroll
    for (int i = 0; i < 4; ++i) { const int e = tid + i * 512, tr = e >> 5, cp = (e & 31) * 2;
      const unsigned w = (unsigned)tile[cp * 66 + tr] | ((unsigned)tile[(cp + 1) * 66 + tr] << 16);
      *(unsigned*)(hy + (size_t)(tok0 + tr) * DHY + ct * 64 + cp) = w; }
  }
  __syncthreads();
}
__device__ void combine_att(const Params& p) {
  const bf16_t* o = (const bf16_t*)((unsigned char*)p.out + DO_Q);
  const float* lse = (const float*)((unsigned char*)p.out + DO_LSE);
  bf16_t* att = (bf16_t*)(p.ws + WS_V);
  int tid = threadIdx.x; asm volatile("" : "+v"(tid));
  const int gt = blockIdx.x * 512 + tid, gs = gridDim.x * 512;
  for (int e = gt; e < MT * 64; e += gs) {
    const int tok = e >> 6, h = (e >> 4) & 3, ch = e & 15;
    const float l0 = lse[tok * 12 + h], l1 = lse[tok * 12 + 4 + h], l2 = lse[tok * 12 + 8 + h];
    const float m = fmaxf(l0, fmaxf(l1, l2));
    float w0 = __expf(l0 - m), w1 = __expf(l1 - m), w2 = __expf(l2 - m);
    const float is = 1.0f / (w0 + w1 + w2); w0 *= is; w1 *= is; w2 *= is;
    const bf16_t* op = o + (size_t)tok * DATT + h * 128 + ch * 8;
    const u32x4 a = *(const u32x4*)op, b = *(const u32x4*)(op + 512), c = *(const u32x4*)(op + 1024);
    u32x4 r;
#pragma unroll
    for (int i = 0; i < 4; ++i) r[i] = cvt_pk_bf16(w0 * bflo(a[i]) + w1 * bflo(b[i]) + w2 * bflo(c[i]), w0 * bfhi(a[i]) + w1 * bfhi(b[i]) + w2 * bfhi(c[i]));
    *(u32x4*)(att + (size_t)tok * DAO + h * 128 + ch * 8) = r;
  }
}


#define XB_TMO      128
#define XB_XCNT(j)  (256  + 64 * (j))
#define XB_XSUB(j)  (1280 + 64 * (j))
#define XB_XGEN(j)  (2304 + 64 * (j))
#define XB_TOP      3328
#define XB_TOPGEN   3392
#define XCD_BAR_WORDS 3456
#define XB_SPIN_CAP (1u << 18)
__device__ __forceinline__ unsigned xb_ld(unsigned* p)              { return __hip_atomic_load(p, __ATOMIC_RELAXED, __HIP_MEMORY_SCOPE_AGENT); }
__device__ __forceinline__ unsigned xb_add(unsigned* p, unsigned v) { return __hip_atomic_fetch_add(p, v, __ATOMIC_RELAXED, __HIP_MEMORY_SCOPE_AGENT); }
__device__ __forceinline__ unsigned xb_xcc_id() { return (unsigned)__builtin_amdgcn_s_getreg((3 << 11) | 20) & 0xFu; }
#define XB_SPIN(cond, bar) do { unsigned _sp = 0; while (cond) { __builtin_amdgcn_s_sleep(1); \
    if ((++_sp & 255u) == 0u) { if (xb_ld(&(bar)[XB_TMO])) break; if (_sp > XB_SPIN_CAP) { atomicAdd(&(bar)[XB_TMO], 1u); break; } } } } while (0)
struct XcdBarrier { unsigned* bar; unsigned x; volatile LAS unsigned* st; };
__device__ __forceinline__ XcdBarrier xcd_barrier_post(unsigned* bar, volatile LAS unsigned* st) {
  XcdBarrier b; b.bar = bar; b.x = xb_xcc_id(); b.st = st;
  if (threadIdx.x == 0) (void)xb_add(&bar[XB_XCNT(b.x)], 1u);
  return b;
}
__device__ __forceinline__ void xcd_barrier_complete(unsigned* bar, unsigned x, unsigned& nloc, unsigned& nx) {
  const unsigned G = gridDim.x * gridDim.y * gridDim.z;
  unsigned sum, cnt, mine, sp = 0u;
  for (;;) {
    sum = 0u; cnt = 0u; mine = 0u;
#pragma unroll
    for (unsigned j = 0; j < 16; ++j) { const unsigned c = xb_ld(&bar[XB_XCNT(j)]); sum += c; cnt += (c > 0u) ? 1u : 0u; mine = (j == x) ? c : mine; }
    if (sum == G) break;
    __builtin_amdgcn_s_sleep(1);
    if ((++sp & 255u) == 0u) { if (xb_ld(&bar[XB_TMO])) break; if (sp > XB_SPIN_CAP) { atomicAdd(&bar[XB_TMO], 1u); break; } }
  }
  nloc = mine > 0u ? mine : 1u; nx = cnt > 0u ? cnt : 1u;
}
__device__ __forceinline__ void xcd_barrier(const XcdBarrier& b) {
  asm volatile("s_waitcnt vmcnt(0)" ::: "memory");
  __syncthreads();
  if (threadIdx.x == 0) {
    unsigned* bar = b.bar;
    __builtin_amdgcn_s_waitcnt(0);
    unsigned nloc = b.st[0], nx = b.st[1];
    if (nloc == 0u) { xcd_barrier_complete(bar, b.x, nloc, nx); b.st[0] = nloc; b.st[1] = nx; }
    const unsigned old = xb_add(&bar[XB_XSUB(b.x)], 1u);
    const unsigned gen = old / nloc;
    if (old + 1u == (gen + 1u) * nloc) {
      __builtin_amdgcn_fence(__ATOMIC_RELEASE, "agent");
      asm volatile("s_waitcnt vmcnt(0)" ::: "memory");
      const unsigned og = xb_add(&bar[XB_TOP], 1u);
      const unsigned tg = og / nx;
      if (og + 1u == (tg + 1u) * nx) xb_add(&bar[XB_TOPGEN], 1u);
      else XB_SPIN(xb_ld(&bar[XB_TOPGEN]) == tg, bar);
      __builtin_amdgcn_fence(__ATOMIC_ACQUIRE, "agent");
      xb_add(&bar[XB_XGEN(b.x)], 1u);
      asm volatile("s_waitcnt vmcnt(0)" ::: "memory");
    } else {
      XB_SPIN(xb_ld(&bar[XB_XGEN(b.x)]) == gen, bar);
      __builtin_amdgcn_fence(__ATOMIC_ACQUIRE, "agent");
      asm volatile("s_waitcnt vmcnt(0)" ::: "memory");
    }
  }
  __syncthreads();
}

constexpr int NPHASE = 14;
__global__ void __launch_bounds__(512, 2) fwd_mega(Params p) {
  extern __shared__ __attribute__((aligned(16))) unsigned char shm[];
  cg::grid_group grid = cg::this_grid();
  unsigned char* ws = p.ws; unsigned char* ob = (unsigned char*)p.out;
  bf16_t* XN = (bf16_t*)(ws + WS_XN); bf16_t* DELTA = (bf16_t*)(ws + WS_DELTA);
  volatile LAS unsigned* xst = (volatile LAS unsigned*)(LAS unsigned char*)(shm + LDS_BYTES - 16);
  if (threadIdx.x == 0) { xst[0] = 0u; xst[1] = 0u; }
  __syncthreads();
  const XcdBarrier xb = xcd_barrier_post((unsigned*)(ws + WS_BAR), xst);
#ifndef DUPMASK
#define DUPMASK 0
#endif
  for (int ph = p.ph_lo; ph < p.ph_hi; ++ph) {
    if (ph != p.ph_lo) { if (p.ph_hi > 1000) grid.sync(); else xcd_barrier(xb); }
    for (int rep = 0; rep < (((DUPMASK >> ph) & 1) ? 2 : 1); ++rep)
    switch (ph) {
      case 0: {
        convert_wt(shm, p.in[4], DM, DFF, 0, DFF, (bf16_t*)(ws + WS_WFFN), 256, 0);
        convert_wt(shm, p.in[5], DM, DFF, 0, DFF, (bf16_t*)(ws + WS_WFFN), 256, 128);
        convert_wt(shm, p.in[6], DFF, DM, 0, DM, (bf16_t*)(ws + WS_WD), 128, 0);
        row_pass<0>(p, nullptr, 0, p.in[2], nullptr, nullptr, XN, nullptr);
        make_tables(p);
      } break;
      case 1: case 11: {
        pg8::EpiSwiGLU E; E.H = (bf16_t*)(ws + WS_BIG);
        run_gemm(shm, XN, (const bf16_t*)(ws + WS_WFFN), MT, 2 * DFF, DM, E, (unsigned*)(ws + WS_QCNT) + (ph) * 128, (int)xb.x);
      } break;
      case 2: case 12: {
        pg8::EpiBf16 E; E.O = XN; E.ldc = DM;
        run_gemm(shm, (const bf16_t*)(ws + WS_BIG), (const bf16_t*)(ws + WS_WD), MT, DM, DFF, E, (unsigned*)(ws + WS_QCNT) + (ph) * 128, (int)xb.x);
      } break;
      case 3: {
        row_pass<1>(p, XN, DM, p.in[3], p.in[7], DELTA, XN, nullptr);
        convert_wt(shm, p.in[9], DM, 11776, 0, 7680, (bf16_t*)(ws + WS_WINHQ), 128, 0);
        convert_wt(shm, p.in[9], DM, 11776, 7680, 2048, (bf16_t*)(ws + WS_WGATES), 256, 0);
        convert_wt(shm, p.in[9], DM, 11776, 9728, 2048, (bf16_t*)(ws + WS_WGATES), 256, 128);
        convert_wt(shm, p.in[21], DHY, DM, 0, DM, (bf16_t*)(ws + WS_WHP), 128, 0);
        convert_wt(shm, p.in[22], DAO, DM, 0, DM, (bf16_t*)(ws + WS_WAP), 128, 0);
        convert_wt(shm, p.in[23], DM, DM, 0, DM, (bf16_t*)(ws + WS_WOUT), 128, 0);
      } break;
      case 4: {
        pg8::EpiInProj E; E.hyT = (bf16_t*)(ws + WS_BIG); E.q = (bf16_t*)(ob + DO_Q); E.k = (bf16_t*)(ob + DO_K); E.v = (bf16_t*)(ws + WS_V); E.rope = (const float2*)(ws + WS_ROPE); E.tl = (LAS unsigned char*)shm + pg8::STAGE_BYTES;
        run_gemm(shm, XN, (const bf16_t*)(ws + WS_WINHQ), MT, 7680, DM, E, (unsigned*)(ws + WS_QCNT) + (ph) * 128, (int)xb.x);
      } break;
      case 5: {
        for (int c0 = blockIdx.x; c0 < 1024; c0 += 4 * gridDim.x) {
          hyena_filters<14>(p, shm, c0, gridDim.x);
          for (int k = 0; k < 4; ++k) if (c0 + k * (int)gridDim.x < 1024) hyena_unit<14, false>(p, shm, c0 + k * gridDim.x, c0 + k * gridDim.x, k, k);
        }
        for (int c0 = blockIdx.x; c0 < 1024; c0 += 4 * gridDim.x) {
          hyena_filters<13>(p, shm, c0, gridDim.x);
          for (int k = 0; k < 4; k += 2) {
            const int ca = c0 + k * (int)gridDim.x; int cb = ca + (int)gridDim.x, kb = k + 1;
            if (cb >= 1024) { cb = ca; kb = k; }
            if (ca < 1024) hyena_unit<13, true>(p, shm, ca, cb, k, kb);
          }
        }
        attention_phase(p, shm);
      } break;
      case 6: {
        transpose_hy(p, shm);
        combine_att(p);
      } break;
      case 7: {
        pg8::EpiTiled E; E.O = (bf16_t*)(ws + WS_BIG);
        run_gemm(shm, (const bf16_t*)(ob + DO_HY), (const bf16_t*)(ws + WS_WHP), MT, DM, DHY, E, (unsigned*)(ws + WS_QCNT) + (ph) * 128, (int)xb.x);
        pg8::EpiTiled E2; E2.O = (bf16_t*)(ws + WS_B);
        run_gemm(shm, (const bf16_t*)(ws + WS_V), (const bf16_t*)(ws + WS_WAP), MT, DM, DAO, E2, (unsigned*)(ws + WS_QCNT) + (14) * 128, (int)xb.x);
      } break;
      case 8: {
        pg8::EpiMerge E; E.Aa = (const bf16_t*)(ws + WS_BIG); E.Bb = (const bf16_t*)(ws + WS_B); E.O = (bf16_t*)(ob + DO_MERGED);
        run_gemm(shm, XN, (const bf16_t*)(ws + WS_WGATES), MT, 4096, DM, E, (unsigned*)(ws + WS_QCNT) + (ph) * 128, (int)xb.x);
      } break;
      case 9: {
        pg8::EpiBf16 E; E.O = XN; E.ldc = DM;
        run_gemm(shm, (const bf16_t*)(ob + DO_MERGED), (const bf16_t*)(ws + WS_WOUT), MT, DM, DM, E, (unsigned*)(ws + WS_QCNT) + (ph) * 128, (int)xb.x);
      } break;
      case 10: {
        row_pass<2>(p, XN, DM, p.in[8], p.in[24], DELTA, XN, nullptr);
        convert_wt(shm, p.in[26], DM, DFF, 0, DFF, (bf16_t*)(ws + WS_WFFN), 256, 0);
        convert_wt(shm, p.in[27], DM, DFF, 0, DFF, (bf16_t*)(ws + WS_WFFN), 256, 128);
        convert_wt(shm, p.in[28], DFF, DM, 0, DM, (bf16_t*)(ws + WS_WD), 128, 0);
      } break;
      case 13: {
        row_pass<3>(p, XN, DM, p.in[25], nullptr, DELTA, nullptr, p.out);
      } break;
    }
  }
}

extern "C" void kernel_launch(void* const* d_in, const int* in_sizes, int n_in, void* d_out, int out_size, void* d_ws, size_t ws_size, hipStream_t stream) {
  static int grid_blocks = 0;
  if (!grid_blocks) {
    int dev = 0, cus = 0, per_cu = 0;
    (void)hipGetDevice(&dev);
    (void)hipDeviceGetAttribute(&cus, hipDeviceAttributeMultiprocessorCount, dev);
    (void)hipFuncSetAttribute((const void*)fwd_mega, hipFuncAttributeMaxDynamicSharedMemorySize, LDS_BYTES);
    (void)hipOccupancyMaxActiveBlocksPerMultiprocessor(&per_cu, (const void*)fwd_mega, 512, LDS_BYTES);
    if (per_cu < 1) per_cu = 1;
    grid_blocks = cus * per_cu;
    if (n_in != 29 || ws_size < WS_NEED) { fprintf(stderr, "kernel_launch: unexpected n_in %d or ws %zu\n", n_in, ws_size); grid_blocks = -1; }
  }
  if (grid_blocks < 0) return;
  (void)hipMemsetAsync((unsigned char*)d_ws + WS_BAR, 0, 32768, stream);
  Params p{};
  for (int i = 0; i < 29; ++i) p.in[i] = (const float*)d_in[i];
  p.out = (float*)d_out; p.ws = (unsigned char*)d_ws; p.ph_lo = 0; p.ph_hi = NPHASE;
  void* args[] = {&p};
  hipError_t e = hipLaunchCooperativeKernel((void*)fwd_mega, dim3(grid_blocks), dim3(512), args, LDS_BYTES, stream);
  if (e != hipSuccess) fprintf(stderr, "cooperative launch failed: %s (grid %d)\n", hipGetErrorString(e), grid_blocks);
}
```

```cpp
#include <hip/hip_runtime.h>
#include <hip/hip_cooperative_groups.h>
#include <cstdio>
namespace cg = cooperative_groups;

#define LAS __attribute__((address_space(3)))
typedef unsigned short bf16_t;
typedef short bf16x8 __attribute__((ext_vector_type(8)));
typedef short bf16x4 __attribute__((ext_vector_type(4)));
typedef float f32x4 __attribute__((ext_vector_type(4)));
typedef unsigned u32x4 __attribute__((ext_vector_type(4)));
typedef unsigned u32x2 __attribute__((ext_vector_type(2)));

constexpr int DM = 2048, DFF = 5632, DHY = 1024, DATT = 1536, DAO = 512;
constexpr int LP = 16384, LSQ = 8192, MP = 2 * LP, MS = 2 * LSQ, MT = MP + MS;
constexpr size_t MiB = (size_t)1 << 20;
constexpr int LDS_BYTES = 150 * 1024;
constexpr int LDS_QSLOT = LDS_BYTES - 32;
constexpr size_t WS_WFFN = 0;
constexpr size_t WS_WD = 44 * MiB;
constexpr size_t WS_WINHQ = 0;
constexpr size_t WS_WGATES = 30 * MiB, WS_WHP = 46 * MiB, WS_WAP = 50 * MiB, WS_WOUT = 52 * MiB;
constexpr size_t WS_XN = 66 * MiB;
constexpr size_t WS_DELTA = 258 * MiB;
constexpr size_t WS_BIG = 450 * MiB;
constexpr size_t WS_V = 738 * MiB;
constexpr size_t WS_B = 786 * MiB;
constexpr size_t WS_SCR1 = 882 * MiB;
constexpr size_t WS_ROPE = 1010 * MiB;
constexpr size_t WS_H3T = 1012 * MiB;
constexpr size_t WS_BAR = 1018 * MiB;
constexpr size_t WS_QCNT = WS_BAR + 16384;
constexpr size_t WS_NEED = 1019 * MiB;
constexpr size_t DO_Q = 0, DO_K = 144 * MiB, DO_LSE = 288 * MiB, DO_Y = 291 * MiB, DO_HY = 144 * MiB, DO_MERGED = 0;

struct Params {
  const float* in[29];
  float* out;
  unsigned char* ws;
  int ph_lo, ph_hi;
};

__device__ __forceinline__ unsigned cvt_pk_bf16(float lo, float hi) { unsigned r; asm volatile("v_cvt_pk_bf16_f32 %0, %1, %2" : "=v"(r) : "v"(lo), "v"(hi)); return r; }
__device__ __forceinline__ bf16_t f2bf(float f) { return (bf16_t)(cvt_pk_bf16(f, 0.f) & 0xffffu); }
__device__ __forceinline__ float bf2f(bf16_t b) { return __uint_as_float(((unsigned)b) << 16); }
__device__ __forceinline__ float bflo(unsigned w) { return __uint_as_float(w << 16); }
__device__ __forceinline__ float bfhi(unsigned w) { return __uint_as_float(w & 0xffff0000u); }
__device__ __forceinline__ float wave_sum(float v) {
#pragma unroll
  for (int o = 32; o > 0; o >>= 1) v += __shfl_xor(v, o);
  return v;
}
__device__ __forceinline__ float sigmoidf_(float x) { return __builtin_amdgcn_rcpf(1.0f + __expf(-x)); }
__device__ __forceinline__ const float* xrow(const Params& p, int tok) { return tok < MP ? p.in[0] + (size_t)tok * DM : p.in[1] + (size_t)(tok - MP) * DM; }

namespace pg8 {
constexpr int BM = 256, BK = 64, HALF = 128, HTB = HALF * BK * 2, STAGE_BYTES = 8 * HTB, NXCD = 8, WGM = 8;
__device__ __forceinline__ int lds_byte(int r, int c) { const int st = (r >> 4) * 2 + (c >> 5), rr = r & 15, cc = c & 31, ob = rr * 64 + cc * 2; return st * 1024 + (ob ^ (((ob >> 9) & 1) << 5)); }
__device__ __forceinline__ void stage_rc(int b, int& R, int& C) { const int st = b / 1024, sb = b % 1024, swz = sb ^ (((sb >> 9) & 1) << 5); R = (st >> 1) * 16 + swz / 64; C = (st & 1) * 32 + (swz % 64) / 2; }
__device__ __forceinline__ int perm32(int rho) { const int n = rho >> 4, i = rho & 15; return 8 * (i >> 2) + 4 * n + (i & 3); }
struct Unit { int pm, pn; };
struct Gemm { const bf16_t* A; const bf16_t* Bt; int M, N, K; };
struct StaticOrder {
  static constexpr bool DYNAMIC = false;
  int nM, nN, nwg, G, c;
  __device__ void init(int M, int N, int G_, int c_) { nM = M / BM; nN = N / BM; nwg = nM * nN; G = G_; c = c_; }
  __device__ bool next(int i, Unit& u) const {
    const long L = (long)i * G + c; if (L >= nwg) return false;
    int wgid = (int)L; { const int q = nwg / NXCD, r = nwg % NXCD, xcd = wgid % NXCD, off = wgid / NXCD; wgid = (xcd < r ? xcd * (q + 1) : r * (q + 1) + (xcd - r) * q) + off; }
    const int nig = WGM * nN, gid = wgid / nig, fm = gid * WGM, gsz = (nM - fm) < WGM ? (nM - fm) : WGM;
    u.pm = fm + ((wgid % nig) % gsz); u.pn = (wgid % nig) / gsz; return true;
  }
};

struct DynOrder {
  static constexpr bool DYNAMIC = true;
  int nM, nN, nwg; unsigned* cnt; int xcc; volatile LAS int* slot;
  __device__ void init(int M, int N, unsigned* cnt_, int xcc_, volatile LAS int* slot_) { nM = M / BM; nN = N / BM; nwg = nM * nN; cnt = cnt_; xcc = xcc_ & (NXCD - 1); slot = slot_; }
  __device__ __forceinline__ unsigned issue() const { return __builtin_amdgcn_atomic_inc32(cnt + xcc * 16, 0xffffffffu, __ATOMIC_RELAXED, "agent"); }
  __device__ int resolve(unsigned off) const {
    const int q = nwg / NXCD, r = nwg % NXCD;
    { const int cy = q + (xcc < r ? 1 : 0), sy = (xcc < r) ? xcc * (q + 1) : r * (q + 1) + (xcc - r) * q; if ((int)off < cy) return sy + (int)off; }
    for (int s = 1; s < NXCD; ++s) {
      const int y = (xcc + s) & (NXCD - 1);
      const int cy = q + (y < r ? 1 : 0), sy = (y < r) ? y * (q + 1) : r * (q + 1) + (y - r) * q;
      const unsigned o2 = __hip_atomic_fetch_add(cnt + y * 16, 1u, __ATOMIC_RELAXED, __HIP_MEMORY_SCOPE_AGENT);
      if ((int)o2 < cy) return sy + (int)o2;
    }
    return -1;
  }
  __device__ void decode(int wgid, Unit& u) const {
    const int nig = WGM * nN, gid = wgid / nig, fm = gid * WGM, gsz = (nM - fm) < WGM ? (nM - fm) : WGM;
    u.pm = fm + ((wgid % nig) % gsz); u.pn = (wgid % nig) / gsz;
  }
};

template <class Epi, class Sched>
__device__ __forceinline__ void gemm_phase(LAS unsigned char* lds, const Gemm g, const Sched& S, const Epi& E) {
  int tid = threadIdx.x; asm volatile("" : "+v"(tid));
  const int wid = __builtin_amdgcn_readfirstlane(tid >> 6), lane = tid & 63, wr = wid >> 2, wc = wid & 3, fr = lane & 15, fq = lane >> 4;
  const int K = g.K, nt = K / BK;
  unsigned voffA[2], voffB[2];
#pragma unroll
  for (int i = 0; i < 2; ++i) { int R, C; stage_rc(tid * 16 + i * 8192, R, C); const int Rb = Epi::PERM ? ((R & ~31) + perm32(R & 31)) : R;
    voffA[i] = (unsigned)(R * K + C) * 2u; voffB[i] = (unsigned)(Rb * BK + C) * 2u; }
  const size_t kstep = (size_t)(BK * 2);
  const size_t hstep = (size_t)HALF * K * 2;
  const size_t tstep = 2 * hstep;
  const size_t kstepB = (size_t)BM * BK * 2, hstepB = (size_t)HALF * BK * 2;
  const unsigned ldsw = (unsigned)wid * 1024u;
  const int aoff = lds_byte(wr * 64 + fr, fq * 8), boff = lds_byte(wc * 32 + fr, fq * 8);
#define PG8_SA(b, h) (((b) * 2 + (h)) * HTB)
#define PG8_SB(b, h) ((4 + (b) * 2 + (h)) * HTB)
#define PG8_STAGE(bufoff, gbase, voff) do { _Pragma("unroll") for (int _i = 0; _i < 2; ++_i) \
    __builtin_amdgcn_global_load_lds((const unsigned*)((const char*)(gbase) + (voff)[_i]), (LAS unsigned*)(lds + (bufoff) + ldsw + _i * 8192), 16, 0, 0); } while (0)
#define PG8_LDA(dst, b, h) do { _Pragma("unroll") for (int m = 0; m < 4; ++m) _Pragma("unroll") for (int k = 0; k < 2; ++k) dst[m][k] = *(const LAS bf16x8*)(lds + PG8_SA(b, h) + aoff + m * 2048 + k * 1024); } while (0)
#define PG8_LDB(dst, b, h) do { _Pragma("unroll") for (int n = 0; n < 2; ++n) _Pragma("unroll") for (int k = 0; k < 2; ++k) dst[n][k] = *(const LAS bf16x8*)(lds + PG8_SB(b, h) + boff + n * 2048 + k * 1024); } while (0)
#define PG8_MMA(ai, bj, At, Bt) do { __builtin_amdgcn_s_setprio(1); _Pragma("unroll") for (int m = 0; m < 4; ++m) _Pragma("unroll") for (int n = 0; n < 2; ++n) _Pragma("unroll") for (int k = 0; k < 2; ++k) \
    acc[ai][bj][m][n] = __builtin_amdgcn_mfma_f32_16x16x32_bf16(Bt[n][k], At[m][k], acc[ai][bj][m][n], 0, 0, 0); __builtin_amdgcn_s_setprio(0); } while (0)
#define PG8_WAIT_V(n) asm volatile("s_waitcnt vmcnt(" #n ")" ::: "memory")
#define PG8_WAIT_L(n) asm volatile("s_waitcnt lgkmcnt(" #n ")" ::: "memory")
#define PG8_BAR __builtin_amdgcn_s_barrier()
#define PG8_SCHED __builtin_amdgcn_sched_barrier(0)
  Unit cur, nxt; int ui = 0; unsigned pend = 0u;
  if constexpr (Sched::DYNAMIC) {
    if (tid == 0) { const int a0 = S.resolve(S.issue()); pend = S.issue(); S.slot[0] = a0; }
    __syncthreads();
    const int w0 = __builtin_amdgcn_readfirstlane(S.slot[0]);
    if (w0 < 0) return;
    S.decode(w0, cur);
  } else { if (!S.next(0, cur)) return; }
  f32x4 acc[2][2][4][2];
#pragma unroll
  for (int a = 0; a < 2; ++a)
#pragma unroll
    for (int b = 0; b < 2; ++b)
#pragma unroll
      for (int m = 0; m < 4; ++m)
#pragma unroll
        for (int n = 0; n < 2; ++n) acc[a][b][m][n] = (f32x4){0.f, 0.f, 0.f, 0.f};
  bf16x8 At[4][2], B0[2][2], B1[2][2];
  const char* cA = (const char*)g.A + (size_t)cur.pm * tstep; const char* cB = (const char*)g.Bt + (size_t)cur.pn * tstep;
  PG8_STAGE(PG8_SB(0, 0), cB, voffB); PG8_STAGE(PG8_SA(0, 0), cA, voffA); PG8_STAGE(PG8_SB(0, 1), cB + hstepB, voffB); PG8_STAGE(PG8_SA(0, 1), cA + hstep, voffA);
  if (wr == 1) PG8_BAR;
  PG8_WAIT_V(4); PG8_BAR;
  PG8_STAGE(PG8_SB(1, 0), cB + kstepB, voffB); PG8_STAGE(PG8_SA(1, 0), cA + kstep, voffA); PG8_STAGE(PG8_SB(1, 1), cB + hstepB + kstepB, voffB);
  PG8_WAIT_V(6); PG8_BAR;
  for (;;) {
    bool has_next;
    if constexpr (Sched::DYNAMIC) {
      if (tid == 0) { S.slot[(ui + 1) & 1] = S.resolve(pend); pend = S.issue(); }
      asm volatile("s_waitcnt lgkmcnt(0)" ::: "memory"); PG8_BAR; asm volatile("" ::: "memory");
      const int w = __builtin_amdgcn_readfirstlane(S.slot[(ui + 1) & 1]);
      has_next = w >= 0; if (has_next) S.decode(w, nxt);
    } else has_next = S.next(ui + 1, nxt);
    const char* nA = has_next ? (const char*)g.A + (size_t)nxt.pm * tstep : cA; const char* nB = has_next ? (const char*)g.Bt + (size_t)nxt.pn * tstep : cB;
    for (int t = 0; t < nt; t += 2) {
      const bool last = (t == nt - 2);
      const char* a1 = cA + (size_t)(t + 1) * kstep;
      const char* a2 = last ? nA : cA + (size_t)(t + 2) * kstep; const char* b2 = last ? nB : cB + (size_t)(t + 2) * kstepB;
      const char* a3 = a2 + kstep; const char* b3 = b2 + kstepB;
      PG8_LDB(B0, 0, 0); PG8_SCHED; PG8_LDA(At, 0, 0); PG8_STAGE(PG8_SA(1, 1), a1 + hstep, voffA);
      PG8_WAIT_L(8); PG8_BAR; PG8_WAIT_L(0); PG8_MMA(0, 0, At, B0); PG8_BAR; PG8_SCHED;
      PG8_LDB(B1, 0, 1); PG8_STAGE(PG8_SB(0, 0), b2, voffB);
      PG8_BAR; PG8_WAIT_L(0); PG8_MMA(0, 1, At, B1); PG8_BAR;
      PG8_LDA(At, 0, 1); PG8_STAGE(PG8_SA(0, 0), a2, voffA);
      PG8_BAR; PG8_WAIT_L(0); PG8_MMA(1, 0, At, B0); PG8_BAR; PG8_SCHED;
      PG8_STAGE(PG8_SB(0, 1), b2 + hstepB, voffB);
      PG8_WAIT_V(6); PG8_BAR; PG8_MMA(1, 1, At, B1); PG8_BAR;
      PG8_LDB(B0, 1, 0); PG8_SCHED; PG8_LDA(At, 1, 0); PG8_STAGE(PG8_SA(0, 1), a2 + hstep, voffA);
      PG8_WAIT_L(8); PG8_BAR; PG8_WAIT_L(0); PG8_MMA(0, 0, At, B0); PG8_BAR; PG8_SCHED;
      PG8_LDB(B1, 1, 1); PG8_STAGE(PG8_SB(1, 0), b3, voffB);
      PG8_BAR; PG8_WAIT_L(0); PG8_MMA(0, 1, At, B1); PG8_BAR;
      PG8_LDA(At, 1, 1); PG8_STAGE(PG8_SA(1, 0), a3, voffA);
      PG8_BAR; PG8_WAIT_L(0); PG8_MMA(1, 0, At, B0); PG8_BAR; PG8_SCHED;
      PG8_STAGE(PG8_SB(1, 1), b3 + hstepB, voffB);
      PG8_WAIT_V(6); PG8_BAR; PG8_MMA(1, 1, At, B1); PG8_BAR;
    }
    E(acc, cur, wr, wc, fr, fq);
    if (!has_next) break;
#pragma unroll
    for (int a = 0; a < 2; ++a)
#pragma unroll
      for (int b = 0; b < 2; ++b)
#pragma unroll
        for (int m = 0; m < 4; ++m)
#pragma unroll
          for (int n = 0; n < 2; ++n) acc[a][b][m][n] = (f32x4){0.f, 0.f, 0.f, 0.f};
    cur = nxt; cA = nA; cB = nB; ++ui;
  }
  PG8_WAIT_V(0);
  if (wr == 0) PG8_BAR;
  PG8_BAR;
#undef PG8_SA
#undef PG8_SB
#undef PG8_STAGE
#undef PG8_LDA
#undef PG8_LDB
#undef PG8_MMA
#undef PG8_WAIT_V
#undef PG8_WAIT_L
#undef PG8_BAR
#undef PG8_SCHED
}

struct EpiF32 {
  static constexpr bool PERM = false;
  float* C; int ldc;
  __device__ __forceinline__ void operator()(const f32x4 (&acc)[2][2][4][2], const Unit& u, int wr, int wc, int fr, int fq) const {
    const int row0 = u.pm * BM + wr * 64 + fr, col0 = u.pn * BM + wc * 32 + 4 * fq;
#pragma unroll
    for (int ai = 0; ai < 2; ++ai)
#pragma unroll
      for (int m = 0; m < 4; ++m) { float* rowp = C + (size_t)(row0 + ai * HALF + m * 16) * ldc + col0;
#pragma unroll
        for (int bj = 0; bj < 2; ++bj)
#pragma unroll
          for (int n = 0; n < 2; ++n) *(f32x4*)(rowp + bj * HALF + n * 16) = acc[ai][bj][m][n]; }
  }
};
struct EpiBf16 {
  static constexpr bool PERM = true;
  bf16_t* O; int ldc;
  __device__ __forceinline__ void operator()(const f32x4 (&acc)[2][2][4][2], const Unit& u, int wr, int wc, int fr, int fq) const {
    const int row0 = u.pm * BM + wr * 64 + fr, col0 = u.pn * BM + wc * 32 + 8 * fq;
#pragma unroll
    for (int ai = 0; ai < 2; ++ai)
#pragma unroll
      for (int m = 0; m < 4; ++m) { bf16_t* rowp = O + (size_t)(row0 + ai * HALF + m * 16) * ldc + col0;
#pragma unroll
        for (int bj = 0; bj < 2; ++bj) { const f32x4 v0 = acc[ai][bj][m][0], v1 = acc[ai][bj][m][1];
          u32x4 w; w.x = cvt_pk_bf16(v0[0], v0[1]); w.y = cvt_pk_bf16(v0[2], v0[3]); w.z = cvt_pk_bf16(v1[0], v1[1]); w.w = cvt_pk_bf16(v1[2], v1[3]);
          *(u32x4*)(rowp + bj * HALF) = w; } }
  }
};
struct EpiTiled {
  static constexpr bool PERM = true;
  bf16_t* O;
  __device__ __forceinline__ void operator()(const f32x4 (&acc)[2][2][4][2], const Unit& u, int wr, int wc, int fr, int fq) const {
    const int wave = wr * 4 + wc, lane = fq * 16 + fr;
#pragma unroll
    for (int ai = 0; ai < 2; ++ai)
#pragma unroll
      for (int m = 0; m < 4; ++m)
#pragma unroll
        for (int bj = 0; bj < 2; ++bj) { const f32x4 v0 = acc[ai][bj][m][0], v1 = acc[ai][bj][m][1];
          u32x4 w; w.x = cvt_pk_bf16(v0[0], v0[1]); w.y = cvt_pk_bf16(v0[2], v0[3]); w.z = cvt_pk_bf16(v1[0], v1[1]); w.w = cvt_pk_bf16(v1[2], v1[3]);
          const size_t idx = ((((size_t)(u.pm * 16 + 2 * u.pn + bj) * 2 + ai) * 4 + m) * 8 + wave) * 64 + lane;
          *(u32x4*)(O + idx * 8) = w; }
  }
};
struct EpiSwiGLU {
  static constexpr bool PERM = true;
  bf16_t* H;
  __device__ __forceinline__ void operator()(const f32x4 (&acc)[2][2][4][2], const Unit& u, int wr, int wc, int fr, int fq) const {
    const int row0 = u.pm * BM + wr * 64 + fr, col0 = u.pn * HALF + wc * 32 + 8 * fq;
#pragma unroll
    for (int ai = 0; ai < 2; ++ai)
#pragma unroll
      for (int m = 0; m < 4; ++m) {
        float h[8];
#pragma unroll
        for (int n = 0; n < 2; ++n)
#pragma unroll
          for (int j = 0; j < 4; ++j) { const float gt = acc[ai][0][m][n][j], up = acc[ai][1][m][n][j]; h[n * 4 + j] = gt * sigmoidf_(gt) * up; }
        u32x4 w; w.x = cvt_pk_bf16(h[0], h[1]); w.y = cvt_pk_bf16(h[2], h[3]); w.z = cvt_pk_bf16(h[4], h[5]); w.w = cvt_pk_bf16(h[6], h[7]);
        *(u32x4*)(H + (size_t)(row0 + ai * HALF + m * 16) * DFF + col0) = w; }
  }
};
struct EpiInProj {
  static constexpr bool PERM = true;
  bf16_t* hyT; bf16_t* q; bf16_t* k; bf16_t* v; const float2* rope; LAS unsigned char* tl;
  __device__ __forceinline__ void operator()(const f32x4 (&acc)[2][2][4][2], const Unit& u, int wr, int wc, int fr, int fq) const {
    const int row0 = u.pm * BM + wr * 64 + fr;
    if (u.pn < 12) {
      const int tok0 = u.pm * BM; size_t base; int L, t0;
      if (tok0 < MP) { L = LP; const int s = tok0 >> 14; t0 = tok0 & (LP - 1); base = (size_t)s * 3072 * LP; }
      else { L = LSQ; const int tk = tok0 - MP, s = tk >> 13; t0 = tk & (LSQ - 1); base = (size_t)2 * 3072 * LP + (size_t)s * 3072 * LSQ; }
      const int wave = wr * 4 + wc, lane = fq * 16 + fr;
      LAS bf16_t* T = (LAS bf16_t*)(tl + wave * 2304);
      bf16_t* gp = hyT + base + t0 + wr * 64;
#pragma unroll
      for (int ai = 0; ai < 2; ++ai)
#pragma unroll
        for (int bj = 0; bj < 2; ++bj)
#pragma unroll
          for (int n = 0; n < 2; ++n) {
#pragma unroll
            for (int m = 0; m < 4; ++m)
#pragma unroll
              for (int j = 0; j < 4; ++j) T[(4 * fq + j) * 72 + 16 * m + fr] = f2bf(acc[ai][bj][m][n][j]);
#pragma unroll
            for (int rr = 0; rr < 2; ++rr) {
              const int chl = (lane >> 3) + 8 * rr, tloc = (lane & 7) * 8;
              const u32x4 w = *(const LAS u32x4*)(T + chl * 72 + tloc);
              const int cabs = u.pn * BM + bj * HALF + wc * 32 + 8 * (chl >> 2) + 4 * n + (chl & 3);
              *(u32x4*)(gp + (size_t)cabs * L + ai * HALF + tloc) = w;
            }
          }
    } else {
      const int cc = (u.pn - 12) * BM, which = cc / DATT, within = cc - which * DATT;
      bf16_t* O = (which == 2) ? v : (q + (size_t)which * ((DO_K - DO_Q) / 2));
      const int col0 = within + wc * 32 + 8 * fq;
      const bool do_rope = (which < 2) && (wc == 0);
      f32x4 cs[4], r16[4];
      if (do_rope) {
        const int pos0 = row0 < MP ? (row0 & (LP - 1)) : ((row0 - MP) & (LSQ - 1));
        const f32x4* tp = (const f32x4*)(rope + pos0 * 16 + 8 * (fq & 1));
        const f32x4* rp = (const f32x4*)(rope + 16 * 16 + 8 * (fq & 1));
#pragma unroll
        for (int e = 0; e < 4; ++e) { cs[e] = tp[e]; r16[e] = rp[e]; }
      }
#pragma unroll
      for (int ai = 0; ai < 2; ++ai)
#pragma unroll
        for (int m = 0; m < 4; ++m) {
          const int row = row0 + ai * HALF + m * 16;
          bf16_t* rowp = O + (size_t)row * DATT + col0;
#pragma unroll
          for (int bj = 0; bj < 2; ++bj) {
            f32x4 v0 = acc[ai][bj][m][0], v1 = acc[ai][bj][m][1];
            if (do_rope) {
#pragma unroll
              for (int e = 0; e < 4; ++e) {
                const float a = v0[e], b = v1[e];
                const float pa = __shfl_xor(a, 32), pb = __shfl_xor(b, 32);
                const float ca = cs[e >> 1][(e & 1) * 2], sa = cs[e >> 1][(e & 1) * 2 + 1], cb = cs[2 + (e >> 1)][(e & 1) * 2], sb = cs[2 + (e >> 1)][(e & 1) * 2 + 1];
                v0[e] = fq < 2 ? a * ca - pa * sa : a * ca + pa * sa;
                v1[e] = fq < 2 ? b * cb - pb * sb : b * cb + pb * sb;
              }
            }
            u32x4 w; w.x = cvt_pk_bf16(v0[0], v0[1]); w.y = cvt_pk_bf16(v0[2], v0[3]); w.z = cvt_pk_bf16(v1[0], v1[1]); w.w = cvt_pk_bf16(v1[2], v1[3]);
            *(u32x4*)(rowp + bj * HALF) = w; }
          if (do_rope) {
            const int steps = (m == 3) ? 5 : 1;
#pragma unroll
            for (int st = 0; st < steps; ++st)
#pragma unroll
              for (int e = 0; e < 4; ++e) {
                const f32x4 c = cs[e], r = r16[e];
                cs[e] = (f32x4){c[0] * r[0] - c[1] * r[1], c[0] * r[1] + c[1] * r[0], c[2] * r[2] - c[3] * r[3], c[2] * r[3] + c[3] * r[2]};
              }
          }
        }
    }
  }
};
struct EpiMerge {
  static constexpr bool PERM = true;
  const bf16_t* Aa; const bf16_t* Bb; bf16_t* O;
  __device__ __forceinline__ void operator()(const f32x4 (&acc)[2][2][4][2], const Unit& u, int wr, int wc, int fr, int fq) const {
    const int row0 = u.pm * BM + wr * 64 + fr, col0 = u.pn * HALF + wc * 32 + 8 * fq;
#pragma unroll
    for (int ai = 0; ai < 2; ++ai) {
      u32x4 av[4], bv[4];
      const int wave = wr * 4 + wc, lane = fq * 16 + fr;
#pragma unroll
      for (int m = 0; m < 4; ++m) { const size_t idx = ((((size_t)(u.pm * 16 + u.pn) * 2 + ai) * 4 + m) * 8 + wave) * 64 + lane; av[m] = *(const u32x4*)(Aa + idx * 8); bv[m] = *(const u32x4*)(Bb + idx * 8); }
#pragma unroll
      for (int m = 0; m < 4; ++m) {
        const size_t off = (size_t)(row0 + ai * HALF + m * 16) * DM + col0;
        float o[8];
#pragma unroll
        for (int n = 0; n < 2; ++n)
#pragma unroll
          for (int j = 0; j < 4; ++j) {
            const int e = n * 4 + j; const unsigned aw = av[m][e >> 1], bw = bv[m][e >> 1];
            const float a = (e & 1) ? bfhi(aw) : bflo(aw), b = (e & 1) ? bfhi(bw) : bflo(bw);
            o[e] = sigmoidf_(acc[ai][0][m][n][j]) * a + sigmoidf_(acc[ai][1][m][n][j]) * b; }
        u32x4 w; w.x = cvt_pk_bf16(o[0], o[1]); w.y = cvt_pk_bf16(o[2], o[3]); w.z = cvt_pk_bf16(o[4], o[5]); w.w = cvt_pk_bf16(o[6], o[7]);
        *(u32x4*)(O + off) = w; }
    }
  }
};
}

template <class Epi>
__device__ __forceinline__ void run_gemm(unsigned char* shm, const bf16_t* A, const bf16_t* Bt, int M, int N, int K, const Epi& E, unsigned* qcnt, int xcc) {
  pg8::Gemm g; g.A = A; g.Bt = Bt; g.M = M; g.N = N; g.K = K;
  pg8::DynOrder S; S.init(M, N, qcnt, xcc, (volatile LAS int*)(LAS unsigned char*)(shm + LDS_QSLOT));
  pg8::gemm_phase<Epi, pg8::DynOrder>((LAS unsigned char*)shm, g, S, E);
}

__device__ void convert_wt(unsigned char* shm, const float* W, int K, int ldw, int c0, int ncols, bf16_t* Bt, int blk, int off) {
  float* tile = (float*)shm;
  int tid = threadIdx.x; asm volatile("" : "+v"(tid));
  const int tk = K / 64, tn = ncols / 64, ntile = tk * tn;
  for (int t = blockIdx.x; t < ntile; t += gridDim.x) {
    const int kt = t % tk, nt_ = t / tk;
    __syncthreads();
#pragma unroll
    for (int i = 0; i < 8; ++i) { const int e = tid + i * 512, r = e >> 6, c = e & 63; tile[r * 65 + c] = W[(size_t)(kt * 64 + r) * ldw + c0 + nt_ * 64 + c]; }
    __syncthreads();
#pragma unroll
    for (int i = 0; i < 4; ++i) { const int e = tid + i * 512, n = e >> 5, kp = (e & 31) * 2; const int c = nt_ * 64 + n;
      const unsigned w = cvt_pk_bf16(tile[kp * 65 + n], tile[(kp + 1) * 65 + n]);
      const int nr = (c >> 7) * blk + off + (c & 127);
      *(unsigned*)(Bt + ((size_t)((nr >> 8) * tk + kt) * 256 + (nr & 255)) * 64 + kp) = w; }
  }
  __syncthreads();
}

template <int MODE>
__device__ void row_pass(const Params& p, const bf16_t* d, int ldd, const float* g0, const float* g1, bf16_t* xs, bf16_t* xn, float* out) {
  int tid = threadIdx.x; asm volatile("" : "+v"(tid));
  const int lane = tid & 63, wv = blockIdx.x * 8 + (tid >> 6), nw = gridDim.x * 8;
  for (int row = wv; row < MT; row += nw) {
    float xv[32];
    if (MODE <= 1) {
      const float* xr = xrow(p, row);
#pragma unroll
      for (int i = 0; i < 8; ++i) { const f32x4 t = *(const f32x4*)(xr + i * 256 + lane * 4); xv[i * 4] = t[0]; xv[i * 4 + 1] = t[1]; xv[i * 4 + 2] = t[2]; xv[i * 4 + 3] = t[3]; }
    } else {
#pragma unroll
      for (int i = 0; i < 8; ++i) { const u32x2 t = *(const u32x2*)(xs + (size_t)row * DM + i * 256 + lane * 4); xv[i * 4] = bflo(t.x); xv[i * 4 + 1] = bfhi(t.x); xv[i * 4 + 2] = bflo(t.y); xv[i * 4 + 3] = bfhi(t.y); }
    }
    if (MODE != 0) {
      float dv[32]; float ss = 0.f;
#pragma unroll
      for (int i = 0; i < 8; ++i) { const u32x2 t = *(const u32x2*)(d + (size_t)row * ldd + i * 256 + lane * 4);
        dv[i * 4] = bflo(t.x); dv[i * 4 + 1] = bfhi(t.x); dv[i * 4 + 2] = bflo(t.y); dv[i * 4 + 3] = bfhi(t.y);
        ss += dv[i * 4] * dv[i * 4] + dv[i * 4 + 1] * dv[i * 4 + 1] + dv[i * 4 + 2] * dv[i * 4 + 2] + dv[i * 4 + 3] * dv[i * 4 + 3]; }
      ss = wave_sum(ss);
      const float rs = rsqrtf(ss * (1.0f / DM) + 1e-6f) * (MODE == 2 ? 1.0f : 0.5f);
#pragma unroll
      for (int i = 0; i < 8; ++i) {
        const f32x4 gg = *(const f32x4*)(g0 + i * 256 + lane * 4);
        float r[4];
#pragma unroll
        for (int j = 0; j < 4; ++j) r[j] = xv[i * 4 + j] + dv[i * 4 + j] * rs * gg[j];
        if (MODE == 3) {
          *(f32x4*)(out + (size_t)row * DM + i * 256 + lane * 4) = (f32x4){r[0], r[1], r[2], r[3]};
        } else {
          const unsigned w0 = cvt_pk_bf16(r[0], r[1]), w1 = cvt_pk_bf16(r[2], r[3]);
          *(u32x2*)(xs + (size_t)row * DM + i * 256 + lane * 4) = (u32x2){w0, w1};
          xv[i * 4] = bflo(w0); xv[i * 4 + 1] = bfhi(w0); xv[i * 4 + 2] = bflo(w1); xv[i * 4 + 3] = bfhi(w1);
        }
      }
    }
    if (MODE != 3) {
      float ss = 0.f;
#pragma unroll
      for (int i = 0; i < 32; ++i) ss += xv[i] * xv[i];
      ss = wave_sum(ss);
      const float rs = rsqrtf(ss * (1.0f / DM) + 1e-6f);
      const float* gn = (MODE == 0) ? g0 : g1;
#pragma unroll
      for (int i = 0; i < 8; ++i) {
        const f32x4 gg = *(const f32x4*)(gn + i * 256 + lane * 4);
        const unsigned w0 = cvt_pk_bf16(xv[i * 4] * rs * gg[0], xv[i * 4 + 1] * rs * gg[1]), w1 = cvt_pk_bf16(xv[i * 4 + 2] * rs * gg[2], xv[i * 4 + 3] * rs * gg[3]);
        *(u32x2*)(xn + (size_t)row * DM + i * 256 + lane * 4) = (u32x2){w0, w1};
      }
    }
  }
}

__device__ void make_tables(const Params& p) {
  float2* rope = (float2*)(p.ws + WS_ROPE);
  int tid = threadIdx.x; asm volatile("" : "+v"(tid));
  const int gt = blockIdx.x * 512 + tid, gs = gridDim.x * 512;
  for (int e = gt; e < LP * 16; e += gs) {
    const int t = e >> 4, i = e & 15;
    const float inv = powf(500000.0f, -(float)i / 16.0f), ang = (float)t * inv;
    float s, c; sincosf(ang, &s, &c); rope[e] = make_float2(c, s);
  }
  float* h3T = (float*)(p.ws + WS_H3T);
  const float *fw1 = p.in[12], *fb1 = p.in[13], *fw2 = p.in[14], *fb2 = p.in[15], *fw3 = p.in[16], *fb3 = p.in[17], *freq = p.in[19];
  const int lane = tid & 63, wv = blockIdx.x * 8 + (tid >> 6), nw = gridDim.x * 8;
  for (int tt = wv; tt < LP + LSQ; tt += nw) {
    const int grp = tt < LP ? 0 : 1, L = grp ? LSQ : LP, n = tt - (grp ? LP : 0);
    const float tn = (float)n / (float)(L - 1), w = (6.283185307179586f / (float)L) * (float)n;
    float z = 0.f;
    if (lane == 0) z = tn;
    else if (lane <= 32) { const int b = (lane - 1) & 15; const float f = 1e-4f + (float)b * ((15.0f - 1e-4f) / 15.0f); z = lane <= 16 ? cosf(f * w) : -sinf(f * w); }
    const float fr = freq[lane];
    float a = fb1[lane];
    for (int i = 0; i < 33; ++i) a += __shfl(z, i) * fw1[i * 64 + lane];
    float h = sinf(fr * a);
    a = fb2[lane];
    for (int i = 0; i < 64; ++i) a += __shfl(h, i) * fw2[i * 64 + lane];
    h = sinf(fr * a);
    a = fb3[lane];
    for (int i = 0; i < 64; ++i) a += __shfl(h, i) * fw3[i * 64 + lane];
    h = sinf(fr * a);
    h3T[(grp ? (size_t)64 * LP : 0) + (size_t)lane * L + n] = h;
  }
}

__device__ __forceinline__ int phys(int i) { return i + (i >> 5); }
__device__ __forceinline__ float2 cmul(float2 a, float2 b) { return make_float2(a.x * b.x - a.y * b.y, a.x * b.y + a.y * b.x); }
__device__ __forceinline__ float2 cmulc(float2 a, float2 b) { return make_float2(a.x * b.x + a.y * b.y, a.y * b.x - a.x * b.y); }
typedef float c32 __attribute__((ext_vector_type(2)));
__device__ __forceinline__ c32 cmul_pk(c32 a, c32 b) {
  c32 t, r;
  asm("v_pk_mul_f32 %0, %1, %2 op_sel:[0,0] op_sel_hi:[0,1]" : "=v"(t) : "v"(a), "v"(b));
  asm("v_pk_fma_f32 %0, %1, %2, %3 op_sel:[1,1,0] op_sel_hi:[1,0,1] neg_lo:[0,1,0]" : "=v"(r) : "v"(a), "v"(b), "v"(t));
  return r;
}
__device__ __forceinline__ float2 twid(float turns) { return make_float2(__builtin_amdgcn_cosf(turns), -__builtin_amdgcn_sinf(turns)); }

template <int R, bool INV>
__device__ __forceinline__ void butterflies(c32 (&v)[1 << R], float turns0) {
  constexpr int RAD = 1 << R;
  constexpr float TC[16] = {1.0f, 0.98078528040f, 0.92387953251f, 0.83146961230f, 0.70710678119f, 0.55557023302f, 0.38268343237f, 0.19509032202f,
                            0.0f, -0.19509032202f, -0.38268343237f, -0.55557023302f, -0.70710678119f, -0.83146961230f, -0.92387953251f, -0.98078528040f};
  constexpr float TS[16] = {0.0f, 0.19509032202f, 0.38268343237f, 0.55557023302f, 0.70710678119f, 0.83146961230f, 0.92387953251f, 0.98078528040f,
                            1.0f, 0.98078528040f, 0.92387953251f, 0.83146961230f, 0.70710678119f, 0.55557023302f, 0.38268343237f, 0.19509032202f};
  float2 tbs[R];
  tbs[0] = twid(turns0);
  if (INV) tbs[0].y = -tbs[0].y;
#pragma unroll
  for (int k = 1; k < R; ++k) tbs[k] = cmul(tbs[k - 1], tbs[k - 1]);
#pragma unroll
  for (int kk = 0; kk < R; ++kk) {
    const int k = INV ? (R - 1 - kk) : kk;
    const int hd = RAD >> (k + 1);
#pragma unroll
    for (int j = 0; j < RAD; ++j) {
      if ((j & hd) == 0) {
        const int m = (j & (hd - 1)) * (16 / hd);
        const float2 c = make_float2(TC[m], INV ? TS[m] : -TS[m]);
        const float2 twf = cmul(tbs[k], c);
        const c32 tw = {twf.x, twf.y};
        const c32 a = v[j], b = v[j + hd];
        if (!INV) { v[j] = a + b; v[j + hd] = cmul_pk(a - b, tw); }
        else { const c32 bt = cmul_pk(b, tw); v[j] = a + bt; v[j + hd] = a - bt; }
      }
    }
  }
}
__device__ __forceinline__ float2 unpk2(unsigned w) { return make_float2(bflo(w), bfhi(w)); }
struct NoLd {};
struct NoF { typedef NoLd Ld; __device__ __forceinline__ float2 operator()(int) const { return make_float2(0.f, 0.f); } __device__ __forceinline__ NoLd load(int) const { return NoLd(); } __device__ __forceinline__ void store(int, float2, const NoLd&) const {} };
template <int LOGN, int R, int DLOG, bool INV, int MODE, class F>
__device__ __forceinline__ void fft_pass(float2* X, const F& f) {
  constexpr int RAD = 1 << R, N = 1 << LOGN, dmin = 1 << DLOG, NGR = N >> R;
  constexpr int PSTEP = (DLOG >= 5) ? ((1 << DLOG) + (1 << (DLOG >= 5 ? DLOG - 5 : 0))) : 0;
  int tid0 = threadIdx.x; asm volatile("" : "+v"(tid0));
  c32* Xc = (c32*)X;
  auto gbase = [&](int g) { const int lo = g & (dmin - 1), hi = g >> DLOG; return (hi << (DLOG + R)) + lo; };
  auto fetch = [&](int g, c32 (&dst)[RAD]) {
    const int base = gbase(g);
#pragma unroll
    for (int j = 0; j < RAD; ++j) { if constexpr (MODE == 1) { const float2 sv = f(base + (j << DLOG)); dst[j] = (c32){sv.x, sv.y}; } }
  };
  c32 nxt[RAD];
  if constexpr (MODE == 1) fetch(tid0, nxt);
#pragma unroll 1
  for (int g = tid0; g < NGR; g += 512) {
    const int lo = g & (dmin - 1), base = gbase(g), pb = phys(base);
    c32 v[RAD];
    if constexpr (MODE == 1) {
#pragma unroll
      for (int j = 0; j < RAD; ++j) v[j] = nxt[j];
      if (g + 512 < NGR) fetch(g + 512, nxt);
    } else {
#pragma unroll
      for (int j = 0; j < RAD; ++j) v[j] = Xc[(DLOG >= 5) ? pb + j * PSTEP : phys(base + (j << DLOG))];
    }
    butterflies<R, INV>(v, (float)lo / (float)(RAD << DLOG));
    if constexpr (MODE == 2) {
      typename F::Ld ld[2][4];
#pragma unroll
      for (int j = 0; j < 4; ++j) ld[0][j] = f.load(base + (j << DLOG));
#pragma unroll
      for (int j0 = 0; j0 < RAD; j0 += 4) {
        constexpr int dummy = 0; (void)dummy;
        const int cur = (j0 >> 2) & 1;
        if (j0 + 4 < RAD) {
#pragma unroll
          for (int j = 0; j < 4; ++j) ld[cur ^ 1][j] = f.load(base + ((j0 + 4 + j) << DLOG));
        }
#pragma unroll
        for (int j = 0; j < 4; ++j) f.store(base + ((j0 + j) << DLOG), make_float2(v[j0 + j].x, v[j0 + j].y), ld[cur][j]);
      }
    } else {
#pragma unroll
      for (int j = 0; j < RAD; ++j) Xc[(DLOG >= 5) ? pb + j * PSTEP : phys(base + (j << DLOG))] = v[j];
    }
  }
  __syncthreads();
}
template <int LOGN>
__device__ __forceinline__ void fft_last_to_regs(const float2* X, c32 (&kf)[32]) {
  static_assert(LOGN == 14, "one radix-32 group per thread");
  const c32* Xc = (const c32*)X;
  int tid0 = threadIdx.x; asm volatile("" : "+v"(tid0));
  const int pb = tid0 * 33;
  c32 v[32];
#pragma unroll
  for (int j = 0; j < 32; ++j) v[j] = Xc[pb + j];
  butterflies<5, false>(v, 0.f);
#pragma unroll
  for (int j = 0; j < 32; ++j) kf[j] = v[j];
  __syncthreads();
}
template <int LOGN>
__device__ __forceinline__ void fft_fused_mul(float2* X, const c32 (&kf)[32]) {
  static_assert(LOGN == 14, "one radix-32 group per thread");
  c32* Xc = (c32*)X;
  int tid0 = threadIdx.x; asm volatile("" : "+v"(tid0));
  const int pb = tid0 * 33;
  c32 v[32];
#pragma unroll
  for (int j = 0; j < 32; ++j) v[j] = Xc[pb + j];
  butterflies<5, false>(v, 0.f);
#pragma unroll
  for (int j = 0; j < 32; ++j) v[j] = cmul_pk(v[j], kf[j]);
  butterflies<5, true>(v, 0.f);
#pragma unroll
  for (int j = 0; j < 32; ++j) Xc[pb + j] = v[j];
  __syncthreads();
}
__device__ __forceinline__ float sconv(const bf16_t* row, int t, int L, float w0, float w1, float w2, float b) {
  const int tm = t > 0 ? t - 1 : 0, tp = t + 1 < L ? t + 1 : L - 1;
  const float vm = bf2f(row[tm]), p0 = bf2f(row[t]), vp = bf2f(row[tp]);
  const float pm = t > 0 ? vm : 0.f, pp = t + 1 < L ? vp : 0.f;
  return pm * w0 + p0 * w1 + pp * w2 + b;
}
struct FiltSrc {
  typedef NoLd Ld;
  const bf16_t* hf; const bf16_t* hb; int L; int lshift; int chstride; int half; float invTurn;
  __device__ __forceinline__ float2 operator()(int i) const {
    const int ch = i >> lshift, t = i & (L - 1);
    const float f = bf2f(hf[ch * chstride + t]), bw = bf2f(hb[ch * chstride + (t > 0 ? L - t : 0)]);
    const float bwm = t > 0 ? bw : 0.f;
    if (half == 0) return make_float2(f + bwm, 0.f);
    const float2 tw = twid((float)t * invTurn); const float d = f - bwm; return make_float2(d * tw.x, d * tw.y);
  }
};
struct DataSrc {
  typedef NoLd Ld;
  const unsigned* Wd; int L; int half; float invTurn;
  __device__ __forceinline__ float2 operator()(int i) const { const float2 wv = unpk2(Wd[i]); return half ? cmul(wv, twid((float)(i & (L - 1)) * invTurn)) : wv; }
};
struct YSink { typedef NoLd Ld; unsigned* Yd; float sc; __device__ __forceinline__ NoLd load(int) const { return NoLd(); } __device__ __forceinline__ void store(int i, float2 v, const NoLd&) const { Yd[i] = cvt_pk_bf16(v.x * sc, v.y * sc); } };
struct GateLd { float2 e, wv; float s0, s1; };
struct GateSink {
  typedef GateLd Ld;
  const unsigned* Yd; unsigned* Wd; const bf16_t* gr0; const bf16_t* gr1; bf16_t* o0; bf16_t* o1; int L; int lshift; int rowdiff; int last;
  float invTurn, inv2L; float bias[2], g0[2], g1[2], g2[2], gb[2];
  __device__ __forceinline__ GateLd load(int i) const {
    const int ch = i >> lshift, t = i & (L - 1);
    const float a0 = ch ? g0[1] : g0[0], a1 = ch ? g1[1] : g1[0], a2 = ch ? g2[1] : g2[0], ab = ch ? gb[1] : gb[0];
    GateLd r; r.e = unpk2(Yd[i]); r.wv = unpk2(Wd[i]); r.s0 = sconv(gr0 + (size_t)ch * rowdiff, t, L, a0, a1, a2, ab); r.s1 = sconv(gr1 + (size_t)ch * rowdiff, t, L, a0, a1, a2, ab); return r;
  }
  __device__ __forceinline__ void store(int i, float2 v, const GateLd& r) const {
    const int ch = i >> lshift, t = i & (L - 1);
    const float bs = ch ? bias[1] : bias[0];
    const float2 o = cmulc(v, twid((float)t * invTurn));
    const float y0 = r.s0 * (r.e.x + o.x * inv2L + bs * r.wv.x), y1 = r.s1 * (r.e.y + o.y * inv2L + bs * r.wv.y);
    if (!last) Wd[i] = cvt_pk_bf16(y0, y1);
    else { o0[(size_t)ch * rowdiff + t] = f2bf(y0); o1[(size_t)ch * rowdiff + t] = f2bf(y1); }
  }
};
template <int LOGN, bool DUAL, bool INV, int MODE, class F>
__device__ __forceinline__ void fft_outer(float2* X, const F& f) {
  if constexpr (DUAL) fft_pass<LOGN + 1, 3, LOGN - 3, INV, MODE, F>(X, f);
  else fft_pass<LOGN, 4, LOGN - 4, INV, MODE, F>(X, f);
}
template <int LOGN, bool INV>
__device__ __forceinline__ void fft_mid(float2* X) {
  static_assert(LOGN == 14, "pass structure 4|3 + 5 + 5");
  NoF nf;
  fft_pass<14, 5, 5, INV, 0, NoF>(X, nf);
}
constexpr size_t DO_W = 323 * MiB;
template <int LOGN>
__device__ void hyena_filters(const Params& p, unsigned char* shm, int c0, int cstride) {
  constexpr int L = 1 << LOGN, grp = (LOGN == 13);
  int tid = threadIdx.x; asm volatile("" : "+v"(tid));
  float* sW = (float*)(shm + 135168);
  const float* __restrict__ h3T = (const float*)(p.ws + WS_H3T) + (grp ? (size_t)64 * LP : 0);
  bf16_t* FSb = (bf16_t*)(p.ws + WS_SCR1 + (size_t)blockIdx.x * (512 * 1024));
  const float* fw4 = p.in[18];
  __syncthreads();
  for (int e = tid; e < 1024; e += 512) { const int j = e >> 4, a = e & 15, k = a >> 2, f = a & 3; int c = c0 + k * cstride; if (c > 1023) c = 1023; sW[e] = fw4[(size_t)j * 4096 + f * 1024 + c]; }
  __syncthreads();
  const float dmin_ = -3.0701134573253944f, dmax_ = -15.350567286626973f;
  const float invL1 = 1.0f / (float)(L - 1);
#pragma unroll 1
  for (int t4 = tid * 4; t4 < L; t4 += 2048) {
    f32x4 acc[16];
#pragma unroll
    for (int a = 0; a < 16; ++a) acc[a] = (f32x4){0.f, 0.f, 0.f, 0.f};
#pragma unroll 1
    for (int j0 = 0; j0 < 64; j0 += 8) {
      f32x4 hv[8];
#pragma unroll
      for (int j = 0; j < 8; ++j) hv[j] = *(const f32x4*)(h3T + (size_t)(j0 + j) * L + t4);
#pragma unroll
      for (int j = 0; j < 8; ++j) {
        const f32x4* wp = (const f32x4*)(sW + (j0 + j) * 16);
#pragma unroll
        for (int q = 0; q < 4; ++q) { const f32x4 w = wp[q]; acc[q * 4] += hv[j] * w[0]; acc[q * 4 + 1] += hv[j] * w[1]; acc[q * 4 + 2] += hv[j] * w[2]; acc[q * 4 + 3] += hv[j] * w[3]; }
      }
    }
#pragma unroll
    for (int k = 0; k < 4; ++k) {
      int c = c0 + k * cstride; if (c > 1023) c = 1023;
      const float delta = fabsf(dmin_ + (float)c * ((dmax_ - dmin_) / 1023.0f));
      f32x4 dec;
#pragma unroll
      for (int e = 0; e < 4; ++e) dec[e] = __expf(-(float)(t4 + e) * invL1 * delta);
#pragma unroll
      for (int f = 0; f < 4; ++f) { const f32x4 v = acc[k * 4 + f] * dec; *(u32x2*)(FSb + (size_t)(k * 4 + f) * L + t4) = (u32x2){cvt_pk_bf16(v[0], v[1]), cvt_pk_bf16(v[2], v[3])}; }
    }
  }
  __syncthreads();
}
template <int LOGN, bool DUAL>
__device__ void hyena_unit(const Params& p, unsigned char* shm, int ca, int cb, int ka, int kb) {
  constexpr int L = 1 << LOGN, grp = (LOGN == 13), LOGX = DUAL ? LOGN + 1 : LOGN, LX = 1 << LOGX;
  int tid = threadIdx.x; asm volatile("" : "+v"(tid));
  float2* X = (float2*)shm;
  bf16_t* hyT = (bf16_t*)(p.ws + WS_BIG) + (grp ? (size_t)2 * 3072 * LP : 0);
  const size_t seqstride = (size_t)3072 * L;
  const bf16_t* FS = (const bf16_t*)(p.ws + WS_SCR1 + (size_t)blockIdx.x * (512 * 1024)) + (size_t)ka * 4 * L;
  const int chstride = (kb - ka) * 4 * L, rowdiff = (cb - ca) * L;
  unsigned* Wd = (unsigned*)((unsigned char*)p.out + DO_W + (size_t)blockIdx.x * (128 * 1024));
  unsigned* Yd = (unsigned*)((unsigned char*)p.out + DO_Y + (size_t)blockIdx.x * (128 * 1024));
  const float *cw = p.in[10], *cb_ = p.in[11], *hbias = p.in[20];
  __syncthreads();
  {
    const float w0a = cw[ca], w1a = cw[3072 + ca], w2a = cw[6144 + ca], bba = cb_[ca];
    const float w0b = cw[cb], w1b = cw[3072 + cb], w2b = cw[6144 + cb], bbb = cb_[cb];
    const bf16_t* r0 = hyT + (size_t)ca * L; const bf16_t* r1 = r0 + seqstride;
#pragma unroll 4
    for (int i = tid; i < LX; i += 512) {
      const int ch = i >> LOGN, t = i & (L - 1);
      const float w0 = ch ? w0b : w0a, w1 = ch ? w1b : w1a, w2 = ch ? w2b : w2a, bb = ch ? bbb : bba;
      Wd[i] = cvt_pk_bf16(sconv(r0 + (size_t)ch * rowdiff, t, L, w0, w1, w2, bb), sconv(r1 + (size_t)ch * rowdiff, t, L, w0, w1, w2, bb));
    }
  }
  __syncthreads();
  const float inv2L = 1.0f / (float)(2 * L), invTurn = 1.0f / (float)(2 * L);
#pragma unroll 1
  for (int n = 0; n < 2; ++n) {
    const int gca = (n + 1) * 1024 + ca, gcb = (n + 1) * 1024 + cb;
    GateSink gs; gs.Yd = Yd; gs.Wd = Wd; gs.gr0 = hyT + (size_t)gca * L; gs.gr1 = gs.gr0 + seqstride; gs.o0 = hyT + (size_t)ca * L; gs.o1 = gs.o0 + seqstride;
    gs.L = L; gs.lshift = LOGN; gs.rowdiff = rowdiff; gs.last = n; gs.invTurn = invTurn; gs.inv2L = inv2L;
    gs.bias[0] = hbias[n * 1024 + ca]; gs.bias[1] = hbias[n * 1024 + cb];
    gs.g0[0] = cw[gca]; gs.g1[0] = cw[3072 + gca]; gs.g2[0] = cw[6144 + gca]; gs.gb[0] = cb_[gca];
    gs.g0[1] = cw[gcb]; gs.g1[1] = cw[3072 + gcb]; gs.g2[1] = cw[6144 + gcb]; gs.gb[1] = cb_[gcb];
#pragma unroll 1
    for (int half = 0; half < 2; ++half) {
      c32 kf[32];
      FiltSrc fs; fs.hf = FS + (size_t)(2 * n) * L; fs.hb = fs.hf + L; fs.L = L; fs.lshift = LOGN; fs.chstride = chstride; fs.half = half; fs.invTurn = invTurn;
      fft_outer<LOGN, DUAL, false, 1>(X, fs);
      fft_mid<LOGX, false>(X);
      fft_last_to_regs<LOGX>(X, kf);
      DataSrc ds; ds.Wd = Wd; ds.L = L; ds.half = half; ds.invTurn = invTurn;
      fft_outer<LOGN, DUAL, false, 1>(X, ds);
      fft_mid<LOGX, false>(X);
      fft_fused_mul<LOGX>(X, kf);
      fft_mid<LOGX, true>(X);
      if (half == 0) { YSink ys; ys.Yd = Yd; ys.sc = inv2L; fft_outer<LOGN, DUAL, true, 2>(X, ys); }
      else fft_outer<LOGN, DUAL, true, 2>(X, gs);
    }
  }
}

constexpr int KP = 136, VP = 200;
struct AttItem { int tokbase, Ls, hc, dil, r, nb, gh; };
__device__ __forceinline__ AttItem att_decode(int it) {
  int seq, rem, L, tokbase;
  if (it < 6144) { seq = it / 3072; rem = it - seq * 3072; L = LP; tokbase = seq * LP; }
  else { const int i2 = it - 6144; seq = i2 / 1536; rem = i2 - seq * 1536; L = LSQ; tokbase = MP + seq * LSQ; }
  const int nblk = L / 64, hd = rem / nblk, blk = rem - hd * nblk, g = hd >> 2, h = hd & 3;
  const int dil = g == 0 ? 1 : (g == 1 ? 4 : 16), nbn = nblk / dil, r = blk / nbn, nb = blk - r * nbn;
  AttItem a; a.tokbase = tokbase; a.Ls = L / dil; a.hc = g * 512 + h * 128; a.dil = dil; a.r = r; a.nb = nb; a.gh = g * 4 + h; return a;
}
__device__ __forceinline__ void att_load(const Params& p, const AttItem& a, int tid, u32x4 (&kq)[8], u32x4 (&vv)[6]) {
  const bf16_t* qg = (const bf16_t*)((unsigned char*)p.out + DO_Q);
  const bf16_t* kg = (const bf16_t*)((unsigned char*)p.out + DO_K);
  const bf16_t* vg = (const bf16_t*)(p.ws + WS_V);
  const int s0 = (a.nb - 1) * 64;
#pragma unroll
  for (int i = 0; i < 8; ++i) {
    const int e = tid + i * 512, row = e >> 4, ch = e & 15;
    u32x4 val = {0u, 0u, 0u, 0u};
    if (row < 192) { const int s = s0 + row; if (s >= 0 && s < a.Ls) val = *(const u32x4*)(kg + (size_t)(a.tokbase + s * a.dil + a.r) * DATT + a.hc + ch * 8); }
    else val = *(const u32x4*)(qg + (size_t)(a.tokbase + (a.nb * 64 + row - 192) * a.dil + a.r) * DATT + a.hc + ch * 8);
    kq[i] = val;
  }
#pragma unroll
  for (int i = 0; i < 6; ++i) {
    const int e = tid + i * 512, ch = e / 192, row = e - ch * 192, s = s0 + row;
    u32x4 val = {0u, 0u, 0u, 0u};
    if (s >= 0 && s < a.Ls) val = *(const u32x4*)(vg + (size_t)(a.tokbase + s * a.dil + a.r) * DATT + a.hc + ch * 8);
    vv[i] = val;
  }
}
__device__ void attention_phase(const Params& p, unsigned char* shm) {
  int tid = threadIdx.x; asm volatile("" : "+v"(tid));
  const int lane = tid & 63, wid = tid >> 6, fr = lane & 15, fq = lane >> 4;
  bf16_t* Ks = (bf16_t*)shm;
  bf16_t* Qs = Ks + 192 * KP;
  bf16_t* Vt = Qs + 64 * KP;
  bf16_t* qg = (bf16_t*)((unsigned char*)p.out + DO_Q);
  float* lse = (float*)((unsigned char*)p.out + DO_LSE);
  u32x4 kq[8], vv[6];
  int it = blockIdx.x;
  if (it >= 9216) return;
  AttItem a = att_decode(it);
  att_load(p, a, tid, kq, vv);
#pragma unroll 1
  for (;;) {
    __syncthreads();
#pragma unroll
    for (int i = 0; i < 8; ++i) { const int e = tid + i * 512, row = e >> 4, ch = e & 15; *(u32x4*)(Ks + row * KP + ch * 8) = kq[i]; }
#pragma unroll
    for (int i = 0; i < 6; ++i) {
      const int e = tid + i * 512, ch = e / 192, row = e - ch * 192;
#pragma unroll
      for (int j = 0; j < 4; ++j) { Vt[(ch * 8 + 2 * j) * VP + row] = (bf16_t)(vv[i][j] & 0xffffu); Vt[(ch * 8 + 2 * j + 1) * VP + row] = (bf16_t)(vv[i][j] >> 16); }
    }
    __syncthreads();
    const AttItem cur = a;
    const int itn = it + gridDim.x;
    const bool has_next = itn < 9216;
    if (has_next) { a = att_decode(itn); att_load(p, a, tid, kq, vv); }
    const int qt = __builtin_amdgcn_readfirstlane(wid & 3), dh = __builtin_amdgcn_readfirstlane(wid >> 2), s0 = (cur.nb - 1) * 64;
    bf16x8 qf[4];
#pragma unroll
    for (int ks = 0; ks < 4; ++ks) qf[ks] = *(const bf16x8*)(Qs + (qt * 16 + fr) * KP + ks * 32 + fq * 8);
    f32x4 sc[12];
#pragma unroll
    for (int kt = 0; kt < 12; ++kt) {
      f32x4 acc = {0.f, 0.f, 0.f, 0.f};
      if (kt >= qt && kt <= qt + 8) {
#pragma unroll
        for (int ks = 0; ks < 4; ++ks) { const bf16x8 kf = *(const bf16x8*)(Ks + (kt * 16 + fr) * KP + ks * 32 + fq * 8); acc = __builtin_amdgcn_mfma_f32_16x16x32_bf16(kf, qf[ks], acc, 0, 0, 0); }
      }
      sc[kt] = acc;
    }
    const int qi = qt * 16 + fr;
    const float scale = 0.08838834764831845f;
    float mx = -3.0e38f;
#pragma unroll
    for (int kt = 0; kt < 12; ++kt)
#pragma unroll
      for (int j = 0; j < 4; ++j) {
        const int kk = kt * 16 + fq * 4 + j, s = s0 + kk;
        const bool ok = (kk >= qi) && (kk <= qi + 128) && (s >= 0) && (s < cur.Ls);
        const float v = ok ? sc[kt][j] * scale : -1e30f;
        sc[kt][j] = v; mx = fmaxf(mx, v);
      }
    mx = fmaxf(mx, __shfl_xor(mx, 16)); mx = fmaxf(mx, __shfl_xor(mx, 32));
    float sum = 0.f;
#pragma unroll
    for (int kt = 0; kt < 12; ++kt)
#pragma unroll
      for (int j = 0; j < 4; ++j) { const float pv = __expf(sc[kt][j] - mx); sc[kt][j] = pv; sum += pv; }
    sum += __shfl_xor(sum, 16); sum += __shfl_xor(sum, 32);
    const float inv = 1.0f / sum;
    f32x4 oacc[4];
#pragma unroll
    for (int dt = 0; dt < 4; ++dt) oacc[dt] = (f32x4){0.f, 0.f, 0.f, 0.f};
#pragma unroll
    for (int kb = 0; kb < 6; ++kb) {
      u32x4 pw; pw.x = cvt_pk_bf16(sc[2 * kb][0], sc[2 * kb][1]); pw.y = cvt_pk_bf16(sc[2 * kb][2], sc[2 * kb][3]); pw.z = cvt_pk_bf16(sc[2 * kb + 1][0], sc[2 * kb + 1][1]); pw.w = cvt_pk_bf16(sc[2 * kb + 1][2], sc[2 * kb + 1][3]);
      const bf16x8 pf = __builtin_bit_cast(bf16x8, pw);
#pragma unroll
      for (int dt = 0; dt < 4; ++dt) {
        const bf16_t* vr = Vt + (dh * 64 + dt * 16 + fr) * VP + kb * 32 + fq * 4;
        const u32x2 lo = *(const u32x2*)vr, hi = *(const u32x2*)(vr + 16);
        const u32x4 vw = {lo.x, lo.y, hi.x, hi.y};
        oacc[dt] = __builtin_amdgcn_mfma_f32_16x16x32_bf16(__builtin_bit_cast(bf16x8, vw), pf, oacc[dt], 0, 0, 0);
      }
    }
    const size_t tok = (size_t)(cur.tokbase + (cur.nb * 64 + qi) * cur.dil + cur.r);
#pragma unroll
    for (int dt = 0; dt < 4; ++dt) {
      const unsigned w0 = cvt_pk_bf16(oacc[dt][0] * inv, oacc[dt][1] * inv), w1 = cvt_pk_bf16(oacc[dt][2] * inv, oacc[dt][3] * inv);
      *(u32x2*)(qg + tok * DATT + cur.hc + dh * 64 + dt * 16 + fq * 4) = (u32x2){w0, w1};
    }
    if (dh == 0 && fq == 0) lse[tok * 12 + cur.gh] = mx + __logf(sum);
    if (!has_next) break;
    it = itn;
  }
  __syncthreads();
}

__device__ void transpose_hy(const Params& p, unsigned char* shm) {
  bf16_t* tile = (bf16_t*)shm;
  const bf16_t* hyT = (const bf16_t*)(p.ws + WS_BIG);
  bf16_t* hy = (bf16_t*)((unsigned char*)p.out + DO_HY);
  int tid = threadIdx.x; asm volatile("" : "+v"(tid));
  const int ntile = (MT / 64) * 16;
  for (int t = blockIdx.x; t < ntile; t += gridDim.x) {
    const int ct = t & 15, tt = t >> 4, tok0 = tt * 64;
    const bf16_t* src; int L;
    if (tok0 < MP) { L = LP; src = hyT + (size_t)(tok0 >> 14) * 3072 * LP + (tok0 & (LP - 1)); }
    else { L = LSQ; const int tk = tok0 - MP; src = hyT + (size_t)2 * 3072 * LP + (size_t)(tk >> 13) * 3072 * LSQ + (tk & (LSQ - 1)); }
    __syncthreads();
#pragma unroll
    for (int i = 0; i < 4; ++i) { const int e = tid + i * 512, cr = e >> 5, tp = (e & 31) * 2; *(unsigned*)(tile + cr * 66 + tp) = *(const unsigned*)(src + (size_t)(ct * 64 + cr) * L + tp); }
    __syncthreads();
#pragma unroll
    for (int i = 0; i < 4; ++i) { const int e = tid + i * 512, tr = e >> 5, cp = (e & 31) * 2;
      const unsigned w = (unsigned)tile[cp * 66 + tr] | ((unsigned)tile[(cp + 1) * 66 + tr] << 16);
      *(unsigned*)(hy + (size_t)(tok0 + tr) * DHY + ct * 64 + cp) = w; }
  }
  __syncthreads();
}
__device__ void combine_att(const Params& p) {
  const bf16_t* o = (const bf16_t*)((unsigned char*)p.out + DO_Q);
  const float* lse = (const float*)((unsigned char*)p.out + DO_LSE);
  bf16_t* att = (bf16_t*)(p.ws + WS_V);
  int tid = threadIdx.x; asm volatile("" : "+v"(tid));
  const int gt = blockIdx.x * 512 + tid, gs = gridDim.x * 512;
  for (int e = gt; e < MT * 64; e += gs) {
    const int tok = e >> 6, h = (e >> 4) & 3, ch = e & 15;
    const float l0 = lse[tok * 12 + h], l1 = lse[tok * 12 + 4 + h], l2 = lse[tok * 12 + 8 + h];
    const float m = fmaxf(l0, fmaxf(l1, l2));
    float w0 = __expf(l0 - m), w1 = __expf(l1 - m), w2 = __expf(l2 - m);
    const float is = 1.0f / (w0 + w1 + w2); w0 *= is; w1 *= is; w2 *= is;
    const bf16_t* op = o + (size_t)tok * DATT + h * 128 + ch * 8;
    const u32x4 a = *(const u32x4*)op, b = *(const u32x4*)(op + 512), c = *(const u32x4*)(op + 1024);
    u32x4 r;
#pragma unroll
    for (int i = 0; i < 4; ++i) r[i] = cvt_pk_bf16(w0 * bflo(a[i]) + w1 * bflo(b[i]) + w2 * bflo(c[i]), w0 * bfhi(a[i]) + w1 * bfhi(b[i]) + w2 * bfhi(c[i]));
    *(u32x4*)(att + (size_t)tok * DAO + h * 128 + ch * 8) = r;
  }
}


#define XB_TMO      128
#define XB_XCNT(j)  (256  + 64 * (j))
#define XB_XSUB(j)  (1280 + 64 * (j))
#define XB_XGEN(j)  (2304 + 64 * (j))
#define XB_TOP      3328
#define XB_TOPGEN   3392
#define XCD_BAR_WORDS 3456
#define XB_SPIN_CAP (1u << 18)
__device__ __forceinline__ unsigned xb_ld(unsigned* p)              { return __hip_atomic_load(p, __ATOMIC_RELAXED, __HIP_MEMORY_SCOPE_AGENT); }
__device__ __forceinline__ unsigned xb_add(unsigned* p, unsigned v) { return __hip_atomic_fetch_add(p, v, __ATOMIC_RELAXED, __HIP_MEMORY_SCOPE_AGENT); }
__device__ __forceinline__ unsigned xb_xcc_id() { return (unsigned)__builtin_amdgcn_s_getreg((3 << 11) | 20) & 0xFu; }
#define XB_SPIN(cond, bar) do { unsigned _sp = 0; while (cond) { __builtin_amdgcn_s_sleep(1); \
    if ((++_sp & 255u) == 0u) { if (xb_ld(&(bar)[XB_TMO])) break; if (_sp > XB_SPIN_CAP) { atomicAdd(&(bar)[XB_TMO], 1u); break; } } } } while (0)
struct XcdBarrier { unsigned* bar; unsigned x; volatile LAS unsigned* st; };
__device__ __forceinline__ XcdBarrier xcd_barrier_post(unsigned* bar, volatile LAS unsigned* st) {
  XcdBarrier b; b.bar = bar; b.x = xb_xcc_id(); b.st = st;
  if (threadIdx.x == 0) (void)xb_add(&bar[XB_XCNT(b.x)], 1u);
  return b;
}
__device__ __forceinline__ void xcd_barrier_complete(unsigned* bar, unsigned x, unsigned& nloc, unsigned& nx) {
  const unsigned G = gridDim.x * gridDim.y * gridDim.z;
  unsigned sum, cnt, mine, sp = 0u;
  for (;;) {
    sum = 0u; cnt = 0u; mine = 0u;
#pragma unroll
    for (unsigned j = 0; j < 16; ++j) { const unsigned c = xb_ld(&bar[XB_XCNT(j)]); sum += c; cnt += (c > 0u) ? 1u : 0u; mine = (j == x) ? c : mine; }
    if (sum == G) break;
    __builtin_amdgcn_s_sleep(1);
    if ((++sp & 255u) == 0u) { if (xb_ld(&bar[XB_TMO])) break; if (sp > XB_SPIN_CAP) { atomicAdd(&bar[XB_TMO], 1u); break; } }
  }
  nloc = mine > 0u ? mine : 1u; nx = cnt > 0u ? cnt : 1u;
}
__device__ __forceinline__ void xcd_barrier(const XcdBarrier& b) {
  asm volatile("s_waitcnt vmcnt(0)" ::: "memory");
  __syncthreads();
  if (threadIdx.x == 0) {
    unsigned* bar = b.bar;
    __builtin_amdgcn_s_waitcnt(0);
    unsigned nloc = b.st[0], nx = b.st[1];
    if (nloc == 0u) { xcd_barrier_complete(bar, b.x, nloc, nx); b.st[0] = nloc; b.st[1] = nx; }
    const unsigned old = xb_add(&bar[XB_XSUB(b.x)], 1u);
    const unsigned gen = old / nloc;
    if (old + 1u == (gen + 1u) * nloc) {
      __builtin_amdgcn_fence(__ATOMIC_RELEASE, "agent");
      asm volatile("s_waitcnt vmcnt(0)" ::: "memory");
      const unsigned og = xb_add(&bar[XB_TOP], 1u);
      const unsigned tg = og / nx;
      if (og + 1u == (tg + 1u) * nx) xb_add(&bar[XB_TOPGEN], 1u);
      else XB_SPIN(xb_ld(&bar[XB_TOPGEN]) == tg, bar);
      __builtin_amdgcn_fence(__ATOMIC_ACQUIRE, "agent");
      xb_add(&bar[XB_XGEN(b.x)], 1u);
      asm volatile("s_waitcnt vmcnt(0)" ::: "memory");
    } else {
      XB_SPIN(xb_ld(&bar[XB_XGEN(b.x)]) == gen, bar);
      __builtin_amdgcn_fence(__ATOMIC_ACQUIRE, "agent");
      asm volatile("s_waitcnt vmcnt(0)" ::: "memory");
    }
  }
  __syncthreads();
}

constexpr int NPHASE = 14;
__global__ void __launch_bounds__(512, 2) fwd_mega(Params p) {
  extern __shared__ __attribute__((aligned(16))) unsigned char shm[];
  cg::grid_group grid = cg::this_grid();
  unsigned char* ws = p.ws; unsigned char* ob = (unsigned char*)p.out;
  bf16_t* XN = (bf16_t*)(ws + WS_XN); bf16_t* DELTA = (bf16_t*)(ws + WS_DELTA);
  volatile LAS unsigned* xst = (volatile LAS unsigned*)(LAS unsigned char*)(shm + LDS_BYTES - 16);
  if (threadIdx.x == 0) { xst[0] = 0u; xst[1] = 0u; }
  __syncthreads();
  const XcdBarrier xb = xcd_barrier_post((unsigned*)(ws + WS_BAR), xst);
#ifndef DUPMASK
#define DUPMASK 0
#endif
  for (int ph = p.ph_lo; ph < p.ph_hi; ++ph) {
    if (ph != p.ph_lo) { if (ph == p.ph_lo + 1) grid.sync(); else xcd_barrier(xb); }
    for (int rep = 0; rep < (((DUPMASK >> ph) & 1) ? 2 : 1); ++rep)
    switch (ph) {
      case 0: {
        convert_wt(shm, p.in[4], DM, DFF, 0, DFF, (bf16_t*)(ws + WS_WFFN), 256, 0);
        convert_wt(shm, p.in[5], DM, DFF, 0, DFF, (bf16_t*)(ws + WS_WFFN), 256, 128);
        convert_wt(shm, p.in[6], DFF, DM, 0, DM, (bf16_t*)(ws + WS_WD), 128, 0);
        row_pass<0>(p, nullptr, 0, p.in[2], nullptr, nullptr, XN, nullptr);
        make_tables(p);
      } break;
      case 1: case 11: {
        pg8::EpiSwiGLU E; E.H = (bf16_t*)(ws + WS_BIG);
        run_gemm(shm, XN, (const bf16_t*)(ws + WS_WFFN), MT, 2 * DFF, DM, E, (unsigned*)(ws + WS_QCNT) + (ph) * 128, (int)xb.x);
      } break;
      case 2: case 12: {
        pg8::EpiBf16 E; E.O = XN; E.ldc = DM;
        run_gemm(shm, (const bf16_t*)(ws + WS_BIG), (const bf16_t*)(ws + WS_WD), MT, DM, DFF, E, (unsigned*)(ws + WS_QCNT) + (ph) * 128, (int)xb.x);
      } break;
      case 3: {
        row_pass<1>(p, XN, DM, p.in[3], p.in[7], DELTA, XN, nullptr);
        convert_wt(shm, p.in[9], DM, 11776, 0, 7680, (bf16_t*)(ws + WS_WINHQ), 128, 0);
        convert_wt(shm, p.in[9], DM, 11776, 7680, 2048, (bf16_t*)(ws + WS_WGATES), 256, 0);
        convert_wt(shm, p.in[9], DM, 11776, 9728, 2048, (bf16_t*)(ws + WS_WGATES), 256, 128);
        convert_wt(shm, p.in[21], DHY, DM, 0, DM, (bf16_t*)(ws + WS_WHP), 128, 0);
        convert_wt(shm, p.in[22], DAO, DM, 0, DM, (bf16_t*)(ws + WS_WAP), 128, 0);
        convert_wt(shm, p.in[23], DM, DM, 0, DM, (bf16_t*)(ws + WS_WOUT), 128, 0);
      } break;
      case 4: {
        pg8::EpiInProj E; E.hyT = (bf16_t*)(ws + WS_BIG); E.q = (bf16_t*)(ob + DO_Q); E.k = (bf16_t*)(ob + DO_K); E.v = (bf16_t*)(ws + WS_V); E.rope = (const float2*)(ws + WS_ROPE); E.tl = (LAS unsigned char*)shm + pg8::STAGE_BYTES;
        run_gemm(shm, XN, (const bf16_t*)(ws + WS_WINHQ), MT, 7680, DM, E, (unsigned*)(ws + WS_QCNT) + (ph) * 128, (int)xb.x);
      } break;
      case 5: {
        for (int c0 = blockIdx.x; c0 < 1024; c0 += 4 * gridDim.x) {
          hyena_filters<14>(p, shm, c0, gridDim.x);
          for (int k = 0; k < 4; ++k) if (c0 + k * (int)gridDim.x < 1024) hyena_unit<14, false>(p, shm, c0 + k * gridDim.x, c0 + k * gridDim.x, k, k);
        }
        for (int c0 = blockIdx.x; c0 < 1024; c0 += 4 * gridDim.x) {
          hyena_filters<13>(p, shm, c0, gridDim.x);
          for (int k = 0; k < 4; k += 2) {
            const int ca = c0 + k * (int)gridDim.x; int cb = ca + (int)gridDim.x, kb = k + 1;
            if (cb >= 1024) { cb = ca; kb = k; }
            if (ca < 1024) hyena_unit<13, true>(p, shm, ca, cb, k, kb);
          }
        }
        attention_phase(p, shm);
      } break;
      case 6: {
        transpose_hy(p, shm);
        combine_att(p);
      } break;
      case 7: {
        pg8::EpiTiled E; E.O = (bf16_t*)(ws + WS_BIG);
        run_gemm(shm, (const bf16_t*)(ob + DO_HY), (const bf16_t*)(ws + WS_WHP), MT, DM, DHY, E, (unsigned*)(ws + WS_QCNT) + (ph) * 128, (int)xb.x);
        pg8::EpiTiled E2; E2.O = (bf16_t*)(ws + WS_B);
        run_gemm(shm, (const bf16_t*)(ws + WS_V), (const bf16_t*)(ws + WS_WAP), MT, DM, DAO, E2, (unsigned*)(ws + WS_QCNT) + (14) * 128, (int)xb.x);
      } break;
      case 8: {
        pg8::EpiMerge E; E.Aa = (const bf16_t*)(ws + WS_BIG); E.Bb = (const bf16_t*)(ws + WS_B); E.O = (bf16_t*)(ob + DO_MERGED);
        run_gemm(shm, XN, (const bf16_t*)(ws + WS_WGATES), MT, 4096, DM, E, (unsigned*)(ws + WS_QCNT) + (ph) * 128, (int)xb.x);
      } break;
      case 9: {
        pg8::EpiBf16 E; E.O = XN; E.ldc = DM;
        run_gemm(shm, (const bf16_t*)(ob + DO_MERGED), (const bf16_t*)(ws + WS_WOUT), MT, DM, DM, E, (unsigned*)(ws + WS_QCNT) + (ph) * 128, (int)xb.x);
      } break;
      case 10: {
        row_pass<2>(p, XN, DM, p.in[8], p.in[24], DELTA, XN, nullptr);
        convert_wt(shm, p.in[26], DM, DFF, 0, DFF, (bf16_t*)(ws + WS_WFFN), 256, 0);
        convert_wt(shm, p.in[27], DM, DFF, 0, DFF, (bf16_t*)(ws + WS_WFFN), 256, 128);
        convert_wt(shm, p.in[28], DFF, DM, 0, DM, (bf16_t*)(ws + WS_WD), 128, 0);
      } break;
      case 13: {
        row_pass<3>(p, XN, DM, p.in[25], nullptr, DELTA, nullptr, p.out);
      } break;
    }
  }
}

extern "C" void kernel_launch(void* const* d_in, const int* in_sizes, int n_in, void* d_out, int out_size, void* d_ws, size_t ws_size, hipStream_t stream) {
  static int grid_blocks = 0;
  if (!grid_blocks) {
    int dev = 0, cus = 0, per_cu = 0;
    (void)hipGetDevice(&dev);
    (void)hipDeviceGetAttribute(&cus, hipDeviceAttributeMultiprocessorCount, dev);
    (void)hipFuncSetAttribute((const void*)fwd_mega, hipFuncAttributeMaxDynamicSharedMemorySize, LDS_BYTES);
    (void)hipOccupancyMaxActiveBlocksPerMultiprocessor(&per_cu, (const void*)fwd_mega, 512, LDS_BYTES);
    if (per_cu < 1) per_cu = 1;
    grid_blocks = cus * per_cu;
    if (n_in != 29 || ws_size < WS_NEED) { fprintf(stderr, "kernel_launch: unexpected n_in %d or ws %zu\n", n_in, ws_size); grid_blocks = -1; }
  }
  if (grid_blocks < 0) return;
  (void)hipMemsetAsync((unsigned char*)d_ws + WS_BAR, 0, 32768, stream);
  Params p{};
  for (int i = 0; i < 29; ++i) p.in[i] = (const float*)d_in[i];
  p.out = (float*)d_out; p.ws = (unsigned char*)d_ws; p.ph_lo = 0; p.ph_hi = NPHASE;
  void* args[] = {&p};
  hipError_t e = hipLaunchCooperativeKernel((void*)fwd_mega, dim3(grid_blocks), dim3(512), args, LDS_BYTES, stream);
  if (e != hipSuccess) fprintf(stderr, "cooperative launch failed: %s (grid %d)\n", hipGetErrorString(e), grid_blocks);
}
```

```cpp
#include <hip/hip_runtime.h>
#include <hip/hip_cooperative_groups.h>
#include <cstdio>
namespace cg = cooperative_groups;

#define LAS __attribute__((address_space(3)))
typedef unsigned short bf16_t;
typedef short bf16x8 __attribute__((ext_vector_type(8)));
typedef short bf16x4 __attribute__((ext_vector_type(4)));
typedef float f32x4 __attribute__((ext_vector_type(4)));
typedef unsigned u32x4 __attribute__((ext_vector_type(4)));
typedef unsigned u32x2 __attribute__((ext_vector_type(2)));

constexpr int DM = 2048, DFF = 5632, DHY = 1024, DATT = 1536, DAO = 512;
constexpr int LP = 16384, LSQ = 8192, MP = 2 * LP, MS = 2 * LSQ, MT = MP + MS;
constexpr size_t MiB = (size_t)1 << 20;
constexpr int LDS_BYTES = 150 * 1024;
constexpr int LDS_QSLOT = LDS_BYTES - 32;
constexpr size_t WS_WFFN = 0;
constexpr size_t WS_WD = 44 * MiB;
constexpr size_t WS_WINHQ = 0;
constexpr size_t WS_WGATES = 30 * MiB, WS_WHP = 46 * MiB, WS_WAP = 50 * MiB, WS_WOUT = 52 * MiB;
constexpr size_t WS_XN = 66 * MiB;
constexpr size_t WS_DELTA = 258 * MiB;
constexpr size_t WS_BIG = 450 * MiB;
constexpr size_t WS_V = 738 * MiB;
constexpr size_t WS_B = 786 * MiB;
constexpr size_t WS_SCR1 = 882 * MiB;
constexpr size_t WS_ROPE = 1010 * MiB;
constexpr size_t WS_H3T = 1012 * MiB;
constexpr size_t WS_BAR = 1018 * MiB;
constexpr size_t WS_QCNT = WS_BAR + 16384;
constexpr size_t WS_NEED = 1019 * MiB;
constexpr size_t DO_Q = 0, DO_K = 144 * MiB, DO_LSE = 288 * MiB, DO_Y = 291 * MiB, DO_HY = 144 * MiB, DO_MERGED = 0;

struct Params {
  const float* in[29];
  float* out;
  unsigned char* ws;
  int ph_lo, ph_hi;
};

__device__ __forceinline__ unsigned cvt_pk_bf16(float lo, float hi) { unsigned r; asm volatile("v_cvt_pk_bf16_f32 %0, %1, %2" : "=v"(r) : "v"(lo), "v"(hi)); return r; }
__device__ __forceinline__ bf16_t f2bf(float f) { return (bf16_t)(cvt_pk_bf16(f, 0.f) & 0xffffu); }
__device__ __forceinline__ float bf2f(bf16_t b) { return __uint_as_float(((unsigned)b) << 16); }
__device__ __forceinline__ float bflo(unsigned w) { return __uint_as_float(w << 16); }
__device__ __forceinline__ float bfhi(unsigned w) { return __uint_as_float(w & 0xffff0000u); }
__device__ __forceinline__ float wave_sum(float v) {
#pragma unroll
  for (int o = 32; o > 0; o >>= 1) v += __shfl_xor(v, o);
  return v;
}
__device__ __forceinline__ float sigmoidf_(float x) { return __builtin_amdgcn_rcpf(1.0f + __expf(-x)); }
__device__ __forceinline__ const float* xrow(const Params& p, int tok) { return tok < MP ? p.in[0] + (size_t)tok * DM : p.in[1] + (size_t)(tok - MP) * DM; }

namespace pg8 {
constexpr int BM = 256, BK = 64, HALF = 128, HTB = HALF * BK * 2, STAGE_BYTES = 8 * HTB, NXCD = 8, WGM = 8;
__device__ __forceinline__ int lds_byte(int r, int c) { const int st = (r >> 4) * 2 + (c >> 5), rr = r & 15, cc = c & 31, ob = rr * 64 + cc * 2; return st * 1024 + (ob ^ (((ob >> 9) & 1) << 5)); }
__device__ __forceinline__ void stage_rc(int b, int& R, int& C) { const int st = b / 1024, sb = b % 1024, swz = sb ^ (((sb >> 9) & 1) << 5); R = (st >> 1) * 16 + swz / 64; C = (st & 1) * 32 + (swz % 64) / 2; }
__device__ __forceinline__ int perm32(int rho) { const int n = rho >> 4, i = rho & 15; return 8 * (i >> 2) + 4 * n + (i & 3); }
struct Unit { int pm, pn; };
struct Gemm { const bf16_t* A; const bf16_t* Bt; int M, N, K; };
struct StaticOrder {
  static constexpr bool DYNAMIC = false;
  int nM, nN, nwg, G, c;
  __device__ void init(int M, int N, int G_, int c_) { nM = M / BM; nN = N / BM; nwg = nM * nN; G = G_; c = c_; }
  __device__ bool next(int i, Unit& u) const {
    const long L = (long)i * G + c; if (L >= nwg) return false;
    int wgid = (int)L; { const int q = nwg / NXCD, r = nwg % NXCD, xcd = wgid % NXCD, off = wgid / NXCD; wgid = (xcd < r ? xcd * (q + 1) : r * (q + 1) + (xcd - r) * q) + off; }
    const int nig = WGM * nN, gid = wgid / nig, fm = gid * WGM, gsz = (nM - fm) < WGM ? (nM - fm) : WGM;
    u.pm = fm + ((wgid % nig) % gsz); u.pn = (wgid % nig) / gsz; return true;
  }
};

struct DynOrder {
  static constexpr bool DYNAMIC = true;
  int nM, nN, nwg; unsigned* cnt; int xcc; volatile LAS int* slot;
  __device__ void init(int M, int N, unsigned* cnt_, int xcc_, volatile LAS int* slot_) { nM = M / BM; nN = N / BM; nwg = nM * nN; cnt = cnt_; xcc = xcc_ & (NXCD - 1); slot = slot_; }
  __device__ __forceinline__ unsigned issue() const { return __builtin_amdgcn_atomic_inc32(cnt + xcc * 16, 0xffffffffu, __ATOMIC_RELAXED, "agent"); }
  __device__ int resolve(unsigned off) const {
    const int q = nwg / NXCD, r = nwg % NXCD;
    { const int cy = q + (xcc < r ? 1 : 0), sy = (xcc < r) ? xcc * (q + 1) : r * (q + 1) + (xcc - r) * q; if ((int)off < cy) return sy + (int)off; }
    for (int s = 1; s < NXCD; ++s) {
      const int y = (xcc + s) & (NXCD - 1);
      const int cy = q + (y < r ? 1 : 0), sy = (y < r) ? y * (q + 1) : r * (q + 1) + (y - r) * q;
      const unsigned o2 = __hip_atomic_fetch_add(cnt + y * 16, 1u, __ATOMIC_RELAXED, __HIP_MEMORY_SCOPE_AGENT);
      if ((int)o2 < cy) return sy + (int)o2;
    }
    return -1;
  }
  __device__ void decode(int wgid, Unit& u) const {
    const int nig = WGM * nN, gid = wgid / nig, fm = gid * WGM, gsz = (nM - fm) < WGM ? (nM - fm) : WGM;
    u.pm = fm + ((wgid % nig) % gsz); u.pn = (wgid % nig) / gsz;
  }
};

template <class Epi, class Sched, bool ABLK = false>
__device__ __forceinline__ void gemm_phase(LAS unsigned char* lds, const Gemm g, const Sched& S, const Epi& E) {
  int tid = threadIdx.x; asm volatile("" : "+v"(tid));
  const int wid = __builtin_amdgcn_readfirstlane(tid >> 6), lane = tid & 63, wr = wid >> 2, wc = wid & 3, fr = lane & 15, fq = lane >> 4;
  const int K = g.K, nt = K / BK;
  unsigned voffA[2], voffB[2];
#pragma unroll
  for (int i = 0; i < 2; ++i) { int R, C; stage_rc(tid * 16 + i * 8192, R, C); const int Rb = Epi::PERM ? ((R & ~31) + perm32(R & 31)) : R;
    voffA[i] = (unsigned)(R * (ABLK ? BK : K) + C) * 2u; voffB[i] = (unsigned)(Rb * BK + C) * 2u; }
  const size_t kstep = ABLK ? (size_t)BM * BK * 2 : (size_t)(BK * 2);
  const size_t hstep = ABLK ? (size_t)HALF * BK * 2 : (size_t)HALF * K * 2;
  const size_t tstep = (size_t)BM * K * 2;
  const size_t kstepB = (size_t)BM * BK * 2, hstepB = (size_t)HALF * BK * 2;
  const unsigned ldsw = (unsigned)wid * 1024u;
  const int aoff = lds_byte(wr * 64 + fr, fq * 8), boff = lds_byte(wc * 32 + fr, fq * 8);
#define PG8_SA(b, h) (((b) * 2 + (h)) * HTB)
#define PG8_SB(b, h) ((4 + (b) * 2 + (h)) * HTB)
#define PG8_STAGE(bufoff, gbase, voff) do { _Pragma("unroll") for (int _i = 0; _i < 2; ++_i) \
    __builtin_amdgcn_global_load_lds((const unsigned*)((const char*)(gbase) + (voff)[_i]), (LAS unsigned*)(lds + (bufoff) + ldsw + _i * 8192), 16, 0, 0); } while (0)
#define PG8_LDA(dst, b, h) do { _Pragma("unroll") for (int m = 0; m < 4; ++m) _Pragma("unroll") for (int k = 0; k < 2; ++k) dst[m][k] = *(const LAS bf16x8*)(lds + PG8_SA(b, h) + aoff + m * 2048 + k * 1024); } while (0)
#define PG8_LDB(dst, b, h) do { _Pragma("unroll") for (int n = 0; n < 2; ++n) _Pragma("unroll") for (int k = 0; k < 2; ++k) dst[n][k] = *(const LAS bf16x8*)(lds + PG8_SB(b, h) + boff + n * 2048 + k * 1024); } while (0)
#define PG8_MMA(ai, bj, At, Bt) do { __builtin_amdgcn_s_setprio(1); _Pragma("unroll") for (int m = 0; m < 4; ++m) _Pragma("unroll") for (int n = 0; n < 2; ++n) _Pragma("unroll") for (int k = 0; k < 2; ++k) \
    acc[ai][bj][m][n] = __builtin_amdgcn_mfma_f32_16x16x32_bf16(Bt[n][k], At[m][k], acc[ai][bj][m][n], 0, 0, 0); __builtin_amdgcn_s_setprio(0); } while (0)
#define PG8_WAIT_V(n) asm volatile("s_waitcnt vmcnt(" #n ")" ::: "memory")
#define PG8_WAIT_L(n) asm volatile("s_waitcnt lgkmcnt(" #n ")" ::: "memory")
#define PG8_BAR __builtin_amdgcn_s_barrier()
#define PG8_SCHED __builtin_amdgcn_sched_barrier(0)
  Unit cur, nxt; int ui = 0; unsigned pend = 0u;
  if constexpr (Sched::DYNAMIC) {
    if (tid == 0) { const int a0 = S.resolve(S.issue()); pend = S.issue(); S.slot[0] = a0; }
    __syncthreads();
    const int w0 = __builtin_amdgcn_readfirstlane(S.slot[0]);
    if (w0 < 0) return;
    S.decode(w0, cur);
  } else { if (!S.next(0, cur)) return; }
  f32x4 acc[2][2][4][2];
#pragma unroll
  for (int a = 0; a < 2; ++a)
#pragma unroll
    for (int b = 0; b < 2; ++b)
#pragma unroll
      for (int m = 0; m < 4; ++m)
#pragma unroll
        for (int n = 0; n < 2; ++n) acc[a][b][m][n] = (f32x4){0.f, 0.f, 0.f, 0.f};
  bf16x8 At[4][2], B0[2][2], B1[2][2];
  const char* cA = (const char*)g.A + (size_t)cur.pm * tstep; const char* cB = (const char*)g.Bt + (size_t)cur.pn * tstep;
  PG8_STAGE(PG8_SB(0, 0), cB, voffB); PG8_STAGE(PG8_SA(0, 0), cA, voffA); PG8_STAGE(PG8_SB(0, 1), cB + hstepB, voffB); PG8_STAGE(PG8_SA(0, 1), cA + hstep, voffA);
  if (wr == 1) PG8_BAR;
  PG8_WAIT_V(4); PG8_BAR;
  PG8_STAGE(PG8_SB(1, 0), cB + kstepB, voffB); PG8_STAGE(PG8_SA(1, 0), cA + kstep, voffA); PG8_STAGE(PG8_SB(1, 1), cB + hstepB + kstepB, voffB);
  PG8_WAIT_V(6); PG8_BAR;
  for (;;) {
    bool has_next;
    if constexpr (Sched::DYNAMIC) {
      if (tid == 0) { S.slot[(ui + 1) & 1] = S.resolve(pend); pend = S.issue(); }
      asm volatile("s_waitcnt lgkmcnt(0)" ::: "memory"); PG8_BAR; asm volatile("" ::: "memory");
      const int w = __builtin_amdgcn_readfirstlane(S.slot[(ui + 1) & 1]);
      has_next = w >= 0; if (has_next) S.decode(w, nxt);
    } else has_next = S.next(ui + 1, nxt);
    const char* nA = has_next ? (const char*)g.A + (size_t)nxt.pm * tstep : cA; const char* nB = has_next ? (const char*)g.Bt + (size_t)nxt.pn * tstep : cB;
    for (int t = 0; t < nt; t += 2) {
      const bool last = (t == nt - 2);
      const char* a1 = cA + (size_t)(t + 1) * kstep;
      const char* a2 = last ? nA : cA + (size_t)(t + 2) * kstep; const char* b2 = last ? nB : cB + (size_t)(t + 2) * kstepB;
      const char* a3 = a2 + kstep; const char* b3 = b2 + kstepB;
      PG8_LDB(B0, 0, 0); PG8_SCHED; PG8_LDA(At, 0, 0); PG8_STAGE(PG8_SA(1, 1), a1 + hstep, voffA);
      PG8_WAIT_L(8); PG8_BAR; PG8_WAIT_L(0); PG8_MMA(0, 0, At, B0); PG8_BAR; PG8_SCHED;
      PG8_LDB(B1, 0, 1); PG8_STAGE(PG8_SB(0, 0), b2, voffB);
      PG8_BAR; PG8_WAIT_L(0); PG8_MMA(0, 1, At, B1); PG8_BAR;
      PG8_LDA(At, 0, 1); PG8_STAGE(PG8_SA(0, 0), a2, voffA);
      PG8_BAR; PG8_WAIT_L(0); PG8_MMA(1, 0, At, B0); PG8_BAR; PG8_SCHED;
      PG8_STAGE(PG8_SB(0, 1), b2 + hstepB, voffB);
      PG8_WAIT_V(6); PG8_BAR; PG8_MMA(1, 1, At, B1); PG8_BAR;
      PG8_LDB(B0, 1, 0); PG8_SCHED; PG8_LDA(At, 1, 0); PG8_STAGE(PG8_SA(0, 1), a2 + hstep, voffA);
      PG8_WAIT_L(8); PG8_BAR; PG8_WAIT_L(0); PG8_MMA(0, 0, At, B0); PG8_BAR; PG8_SCHED;
      PG8_LDB(B1, 1, 1); PG8_STAGE(PG8_SB(1, 0), b3, voffB);
      PG8_BAR; PG8_WAIT_L(0); PG8_MMA(0, 1, At, B1); PG8_BAR;
      PG8_LDA(At, 1, 1); PG8_STAGE(PG8_SA(1, 0), a3, voffA);
      PG8_BAR; PG8_WAIT_L(0); PG8_MMA(1, 0, At, B0); PG8_BAR; PG8_SCHED;
      PG8_STAGE(PG8_SB(1, 1), b3 + hstepB, voffB);
      PG8_WAIT_V(6); PG8_BAR; PG8_MMA(1, 1, At, B1); PG8_BAR;
    }
    E(acc, cur, wr, wc, fr, fq);
    if (!has_next) break;
#pragma unroll
    for (int a = 0; a < 2; ++a)
#pragma unroll
      for (int b = 0; b < 2; ++b)
#pragma unroll
        for (int m = 0; m < 4; ++m)
#pragma unroll
          for (int n = 0; n < 2; ++n) acc[a][b][m][n] = (f32x4){0.f, 0.f, 0.f, 0.f};
    cur = nxt; cA = nA; cB = nB; ++ui;
  }
  PG8_WAIT_V(0);
  if (wr == 0) PG8_BAR;
  PG8_BAR;
#undef PG8_SA
#undef PG8_SB
#undef PG8_STAGE
#undef PG8_LDA
#undef PG8_LDB
#undef PG8_MMA
#undef PG8_WAIT_V
#undef PG8_WAIT_L
#undef PG8_BAR
#undef PG8_SCHED
}

struct EpiF32 {
  static constexpr bool PERM = false;
  float* C; int ldc;
  __device__ __forceinline__ void operator()(const f32x4 (&acc)[2][2][4][2], const Unit& u, int wr, int wc, int fr, int fq) const {
    const int row0 = u.pm * BM + wr * 64 + fr, col0 = u.pn * BM + wc * 32 + 4 * fq;
#pragma unroll
    for (int ai = 0; ai < 2; ++ai)
#pragma unroll
      for (int m = 0; m < 4; ++m) { float* rowp = C + (size_t)(row0 + ai * HALF + m * 16) * ldc + col0;
#pragma unroll
        for (int bj = 0; bj < 2; ++bj)
#pragma unroll
          for (int n = 0; n < 2; ++n) *(f32x4*)(rowp + bj * HALF + n * 16) = acc[ai][bj][m][n]; }
  }
};
struct EpiBf16 {
  static constexpr bool PERM = true;
  bf16_t* O; int ldc;
  __device__ __forceinline__ void operator()(const f32x4 (&acc)[2][2][4][2], const Unit& u, int wr, int wc, int fr, int fq) const {
    const int row0 = u.pm * BM + wr * 64 + fr, col0 = u.pn * BM + wc * 32 + 8 * fq;
#pragma unroll
    for (int ai = 0; ai < 2; ++ai)
#pragma unroll
      for (int m = 0; m < 4; ++m) { bf16_t* rowp = O + (size_t)(row0 + ai * HALF + m * 16) * ldc + col0;
#pragma unroll
        for (int bj = 0; bj < 2; ++bj) { const f32x4 v0 = acc[ai][bj][m][0], v1 = acc[ai][bj][m][1];
          u32x4 w; w.x = cvt_pk_bf16(v0[0], v0[1]); w.y = cvt_pk_bf16(v0[2], v0[3]); w.z = cvt_pk_bf16(v1[0], v1[1]); w.w = cvt_pk_bf16(v1[2], v1[3]);
          *(u32x4*)(rowp + bj * HALF) = w; } }
  }
};
struct EpiTiled {
  static constexpr bool PERM = true;
  bf16_t* O;
  __device__ __forceinline__ void operator()(const f32x4 (&acc)[2][2][4][2], const Unit& u, int wr, int wc, int fr, int fq) const {
    const int wave = wr * 4 + wc, lane = fq * 16 + fr;
#pragma unroll
    for (int ai = 0; ai < 2; ++ai)
#pragma unroll
      for (int m = 0; m < 4; ++m)
#pragma unroll
        for (int bj = 0; bj < 2; ++bj) { const f32x4 v0 = acc[ai][bj][m][0], v1 = acc[ai][bj][m][1];
          u32x4 w; w.x = cvt_pk_bf16(v0[0], v0[1]); w.y = cvt_pk_bf16(v0[2], v0[3]); w.z = cvt_pk_bf16(v1[0], v1[1]); w.w = cvt_pk_bf16(v1[2], v1[3]);
          const size_t idx = ((((size_t)(u.pm * 16 + 2 * u.pn + bj) * 2 + ai) * 4 + m) * 8 + wave) * 64 + lane;
          *(u32x4*)(O + idx * 8) = w; }
  }
};
struct EpiSwiGLU {
  static constexpr bool PERM = true;
  bf16_t* H;
  __device__ __forceinline__ void operator()(const f32x4 (&acc)[2][2][4][2], const Unit& u, int wr, int wc, int fr, int fq) const {
    const int row0 = u.pm * BM + wr * 64 + fr, col0 = u.pn * HALF + wc * 32 + 8 * fq;
#pragma unroll
    for (int ai = 0; ai < 2; ++ai)
#pragma unroll
      for (int m = 0; m < 4; ++m) {
        float h[8];
#pragma unroll
        for (int n = 0; n < 2; ++n)
#pragma unroll
          for (int j = 0; j < 4; ++j) { const float gt = acc[ai][0][m][n][j], up = acc[ai][1][m][n][j]; h[n * 4 + j] = gt * sigmoidf_(gt) * up; }
        u32x4 w; w.x = cvt_pk_bf16(h[0], h[1]); w.y = cvt_pk_bf16(h[2], h[3]); w.z = cvt_pk_bf16(h[4], h[5]); w.w = cvt_pk_bf16(h[6], h[7]);
        const int rloc = wr * 64 + fr + ai * HALF + m * 16;
        *(u32x4*)(H + ((size_t)(u.pm * (DFF / 64) + (col0 >> 6)) * 256 + rloc) * 64 + (col0 & 63)) = w; }
  }
};
struct EpiInProj {
  static constexpr bool PERM = true;
  bf16_t* hyT; bf16_t* q; bf16_t* k; bf16_t* v; const float2* rope; LAS unsigned char* tl;
  __device__ __forceinline__ void operator()(const f32x4 (&acc)[2][2][4][2], const Unit& u, int wr, int wc, int fr, int fq) const {
    const int row0 = u.pm * BM + wr * 64 + fr;
    if (u.pn < 12) {
      const int tok0 = u.pm * BM; size_t base; int L, t0;
      if (tok0 < MP) { L = LP; const int s = tok0 >> 14; t0 = tok0 & (LP - 1); base = (size_t)s * 3072 * LP; }
      else { L = LSQ; const int tk = tok0 - MP, s = tk >> 13; t0 = tk & (LSQ - 1); base = (size_t)2 * 3072 * LP + (size_t)s * 3072 * LSQ; }
      const int wave = wr * 4 + wc, lane = fq * 16 + fr;
      LAS bf16_t* T = (LAS bf16_t*)(tl + wave * 2304);
      bf16_t* gp = hyT + base + t0 + wr * 64;
#pragma unroll
      for (int ai = 0; ai < 2; ++ai)
#pragma unroll
        for (int bj = 0; bj < 2; ++bj)
#pragma unroll
          for (int n = 0; n < 2; ++n) {
#pragma unroll
            for (int m = 0; m < 4; ++m)
#pragma unroll
              for (int j = 0; j < 4; ++j) T[(4 * fq + j) * 72 + 16 * m + fr] = f2bf(acc[ai][bj][m][n][j]);
#pragma unroll
            for (int rr = 0; rr < 2; ++rr) {
              const int chl = (lane >> 3) + 8 * rr, tloc = (lane & 7) * 8;
              const u32x4 w = *(const LAS u32x4*)(T + chl * 72 + tloc);
              const int cabs = u.pn * BM + bj * HALF + wc * 32 + 8 * (chl >> 2) + 4 * n + (chl & 3);
              *(u32x4*)(gp + (size_t)cabs * L + ai * HALF + tloc) = w;
            }
          }
    } else {
      const int cc = (u.pn - 12) * BM, which = cc / DATT, within = cc - which * DATT;
      bf16_t* O = (which == 2) ? v : (q + (size_t)which * ((DO_K - DO_Q) / 2));
      const int col0 = within + wc * 32 + 8 * fq;
      const bool do_rope = (which < 2) && (wc == 0);
      f32x4 cs[4], r16[4];
      if (do_rope) {
        const int pos0 = row0 < MP ? (row0 & (LP - 1)) : ((row0 - MP) & (LSQ - 1));
        const f32x4* tp = (const f32x4*)(rope + pos0 * 16 + 8 * (fq & 1));
        const f32x4* rp = (const f32x4*)(rope + 16 * 16 + 8 * (fq & 1));
#pragma unroll
        for (int e = 0; e < 4; ++e) { cs[e] = tp[e]; r16[e] = rp[e]; }
      }
#pragma unroll
      for (int ai = 0; ai < 2; ++ai)
#pragma unroll
        for (int m = 0; m < 4; ++m) {
          const int row = row0 + ai * HALF + m * 16;
          bf16_t* rowp = O + (size_t)row * DATT + col0;
#pragma unroll
          for (int bj = 0; bj < 2; ++bj) {
            f32x4 v0 = acc[ai][bj][m][0], v1 = acc[ai][bj][m][1];
            if (do_rope) {
#pragma unroll
              for (int e = 0; e < 4; ++e) {
                const float a = v0[e], b = v1[e];
                const float pa = __shfl_xor(a, 32), pb = __shfl_xor(b, 32);
                const float ca = cs[e >> 1][(e & 1) * 2], sa = cs[e >> 1][(e & 1) * 2 + 1], cb = cs[2 + (e >> 1)][(e & 1) * 2], sb = cs[2 + (e >> 1)][(e & 1) * 2 + 1];
                v0[e] = fq < 2 ? a * ca - pa * sa : a * ca + pa * sa;
                v1[e] = fq < 2 ? b * cb - pb * sb : b * cb + pb * sb;
              }
            }
            u32x4 w; w.x = cvt_pk_bf16(v0[0], v0[1]); w.y = cvt_pk_bf16(v0[2], v0[3]); w.z = cvt_pk_bf16(v1[0], v1[1]); w.w = cvt_pk_bf16(v1[2], v1[3]);
            *(u32x4*)(rowp + bj * HALF) = w; }
          if (do_rope) {
            const int steps = (m == 3) ? 5 : 1;
#pragma unroll
            for (int st = 0; st < steps; ++st)
#pragma unroll
              for (int e = 0; e < 4; ++e) {
                const f32x4 c = cs[e], r = r16[e];
                cs[e] = (f32x4){c[0] * r[0] - c[1] * r[1], c[0] * r[1] + c[1] * r[0], c[2] * r[2] - c[3] * r[3], c[2] * r[3] + c[3] * r[2]};
              }
          }
        }
    }
  }
};
struct EpiMerge {
  static constexpr bool PERM = true;
  const bf16_t* Aa; const bf16_t* Bb; bf16_t* O;
  __device__ __forceinline__ void operator()(const f32x4 (&acc)[2][2][4][2], const Unit& u, int wr, int wc, int fr, int fq) const {
    const int row0 = u.pm * BM + wr * 64 + fr, col0 = u.pn * HALF + wc * 32 + 8 * fq;
#pragma unroll
    for (int ai = 0; ai < 2; ++ai) {
      u32x4 av[4], bv[4];
      const int wave = wr * 4 + wc, lane = fq * 16 + fr;
#pragma unroll
      for (int m = 0; m < 4; ++m) { const size_t idx = ((((size_t)(u.pm * 16 + u.pn) * 2 + ai) * 4 + m) * 8 + wave) * 64 + lane; av[m] = *(const u32x4*)(Aa + idx * 8); bv[m] = *(const u32x4*)(Bb + idx * 8); }
#pragma unroll
      for (int m = 0; m < 4; ++m) {
        const size_t off = (size_t)(row0 + ai * HALF + m * 16) * DM + col0;
        float o[8];
#pragma unroll
        for (int n = 0; n < 2; ++n)
#pragma unroll
          for (int j = 0; j < 4; ++j) {
            const int e = n * 4 + j; const unsigned aw = av[m][e >> 1], bw = bv[m][e >> 1];
            const float a = (e & 1) ? bfhi(aw) : bflo(aw), b = (e & 1) ? bfhi(bw) : bflo(bw);
            o[e] = sigmoidf_(acc[ai][0][m][n][j]) * a + sigmoidf_(acc[ai][1][m][n][j]) * b; }
        u32x4 w; w.x = cvt_pk_bf16(o[0], o[1]); w.y = cvt_pk_bf16(o[2], o[3]); w.z = cvt_pk_bf16(o[4], o[5]); w.w = cvt_pk_bf16(o[6], o[7]);
        *(u32x4*)(O + off) = w; }
    }
  }
};
}

template <class Epi, bool ABLK = false>
__device__ __forceinline__ void run_gemm(unsigned char* shm, const bf16_t* A, const bf16_t* Bt, int M, int N, int K, const Epi& E, unsigned* qcnt, int xcc) {
  pg8::Gemm g; g.A = A; g.Bt = Bt; g.M = M; g.N = N; g.K = K;
  pg8::DynOrder S; S.init(M, N, qcnt, xcc, (volatile LAS int*)(LAS unsigned char*)(shm + LDS_QSLOT));
  pg8::gemm_phase<Epi, pg8::DynOrder, ABLK>((LAS unsigned char*)shm, g, S, E);
}

__device__ void convert_wt(unsigned char* shm, const float* W, int K, int ldw, int c0, int ncols, bf16_t* Bt, int blk, int off) {
  float* tile = (float*)shm;
  int tid = threadIdx.x; asm volatile("" : "+v"(tid));
  const int tk = K / 64, tn = ncols / 64, ntile = tk * tn;
  for (int t = blockIdx.x; t < ntile; t += gridDim.x) {
    const int kt = t % tk, nt_ = t / tk;
    __syncthreads();
#pragma unroll
    for (int i = 0; i < 8; ++i) { const int e = tid + i * 512, r = e >> 6, c = e & 63; tile[r * 65 + c] = W[(size_t)(kt * 64 + r) * ldw + c0 + nt_ * 64 + c]; }
    __syncthreads();
#pragma unroll
    for (int i = 0; i < 4; ++i) { const int e = tid + i * 512, n = e >> 5, kp = (e & 31) * 2; const int c = nt_ * 64 + n;
      const unsigned w = cvt_pk_bf16(tile[kp * 65 + n], tile[(kp + 1) * 65 + n]);
      const int nr = (c >> 7) * blk + off + (c & 127);
      *(unsigned*)(Bt + ((size_t)((nr >> 8) * tk + kt) * 256 + (nr & 255)) * 64 + kp) = w; }
  }
  __syncthreads();
}

template <int MODE>
__device__ void row_pass(const Params& p, const bf16_t* d, int ldd, const float* g0, const float* g1, bf16_t* xs, bf16_t* xn, float* out) {
  int tid = threadIdx.x; asm volatile("" : "+v"(tid));
  const int lane = tid & 63, wv = blockIdx.x * 8 + (tid >> 6), nw = gridDim.x * 8;
  for (int row = wv; row < MT; row += nw) {
    float xv[32];
    if (MODE <= 1) {
      const float* xr = xrow(p, row);
#pragma unroll
      for (int i = 0; i < 8; ++i) { const f32x4 t = *(const f32x4*)(xr + i * 256 + lane * 4); xv[i * 4] = t[0]; xv[i * 4 + 1] = t[1]; xv[i * 4 + 2] = t[2]; xv[i * 4 + 3] = t[3]; }
    } else {
#pragma unroll
      for (int i = 0; i < 8; ++i) { const u32x2 t = *(const u32x2*)(xs + (size_t)row * DM + i * 256 + lane * 4); xv[i * 4] = bflo(t.x); xv[i * 4 + 1] = bfhi(t.x); xv[i * 4 + 2] = bflo(t.y); xv[i * 4 + 3] = bfhi(t.y); }
    }
    if (MODE != 0) {
      float dv[32]; float ss = 0.f;
#pragma unroll
      for (int i = 0; i < 8; ++i) { const u32x2 t = *(const u32x2*)(d + (size_t)row * ldd + i * 256 + lane * 4);
        dv[i * 4] = bflo(t.x); dv[i * 4 + 1] = bfhi(t.x); dv[i * 4 + 2] = bflo(t.y); dv[i * 4 + 3] = bfhi(t.y);
        ss += dv[i * 4] * dv[i * 4] + dv[i * 4 + 1] * dv[i * 4 + 1] + dv[i * 4 + 2] * dv[i * 4 + 2] + dv[i * 4 + 3] * dv[i * 4 + 3]; }
      ss = wave_sum(ss);
      const float rs = rsqrtf(ss * (1.0f / DM) + 1e-6f) * (MODE == 2 ? 1.0f : 0.5f);
#pragma unroll
      for (int i = 0; i < 8; ++i) {
        const f32x4 gg = *(const f32x4*)(g0 + i * 256 + lane * 4);
        float r[4];
#pragma unroll
        for (int j = 0; j < 4; ++j) r[j] = xv[i * 4 + j] + dv[i * 4 + j] * rs * gg[j];
        if (MODE == 3) {
          *(f32x4*)(out + (size_t)row * DM + i * 256 + lane * 4) = (f32x4){r[0], r[1], r[2], r[3]};
        } else {
          const unsigned w0 = cvt_pk_bf16(r[0], r[1]), w1 = cvt_pk_bf16(r[2], r[3]);
          *(u32x2*)(xs + (size_t)row * DM + i * 256 + lane * 4) = (u32x2){w0, w1};
          xv[i * 4] = bflo(w0); xv[i * 4 + 1] = bfhi(w0); xv[i * 4 + 2] = bflo(w1); xv[i * 4 + 3] = bfhi(w1);
        }
      }
    }
    if (MODE != 3) {
      float ss = 0.f;
#pragma unroll
      for (int i = 0; i < 32; ++i) ss += xv[i] * xv[i];
      ss = wave_sum(ss);
      const float rs = rsqrtf(ss * (1.0f / DM) + 1e-6f);
      const float* gn = (MODE == 0) ? g0 : g1;
#pragma unroll
      for (int i = 0; i < 8; ++i) {
        const f32x4 gg = *(const f32x4*)(gn + i * 256 + lane * 4);
        const unsigned w0 = cvt_pk_bf16(xv[i * 4] * rs * gg[0], xv[i * 4 + 1] * rs * gg[1]), w1 = cvt_pk_bf16(xv[i * 4 + 2] * rs * gg[2], xv[i * 4 + 3] * rs * gg[3]);
        *(u32x2*)(xn + (size_t)row * DM + i * 256 + lane * 4) = (u32x2){w0, w1};
      }
    }
  }
}

__device__ void make_tables(const Params& p) {
  float2* rope = (float2*)(p.ws + WS_ROPE);
  int tid = threadIdx.x; asm volatile("" : "+v"(tid));
  const int gt = blockIdx.x * 512 + tid, gs = gridDim.x * 512;
  for (int e = gt; e < LP * 16; e += gs) {
    const int t = e >> 4, i = e & 15;
    const float inv = powf(500000.0f, -(float)i / 16.0f), ang = (float)t * inv;
    float s, c; sincosf(ang, &s, &c); rope[e] = make_float2(c, s);
  }
  float* h3T = (float*)(p.ws + WS_H3T);
  const float *fw1 = p.in[12], *fb1 = p.in[13], *fw2 = p.in[14], *fb2 = p.in[15], *fw3 = p.in[16], *fb3 = p.in[17], *freq = p.in[19];
  const int lane = tid & 63, wv = blockIdx.x * 8 + (tid >> 6), nw = gridDim.x * 8;
  for (int tt = wv; tt < LP + LSQ; tt += nw) {
    const int grp = tt < LP ? 0 : 1, L = grp ? LSQ : LP, n = tt - (grp ? LP : 0);
    const float tn = (float)n / (float)(L - 1), w = (6.283185307179586f / (float)L) * (float)n;
    float z = 0.f;
    if (lane == 0) z = tn;
    else if (lane <= 32) { const int b = (lane - 1) & 15; const float f = 1e-4f + (float)b * ((15.0f - 1e-4f) / 15.0f); z = lane <= 16 ? cosf(f * w) : -sinf(f * w); }
    const float fr = freq[lane];
    float a = fb1[lane];
    for (int i = 0; i < 33; ++i) a += __shfl(z, i) * fw1[i * 64 + lane];
    float h = sinf(fr * a);
    a = fb2[lane];
    for (int i = 0; i < 64; ++i) a += __shfl(h, i) * fw2[i * 64 + lane];
    h = sinf(fr * a);
    a = fb3[lane];
    for (int i = 0; i < 64; ++i) a += __shfl(h, i) * fw3[i * 64 + lane];
    h = sinf(fr * a);
    h3T[(grp ? (size_t)64 * LP : 0) + (size_t)lane * L + n] = h;
  }
}

__device__ __forceinline__ int phys(int i) { return i + (i >> 5); }
__device__ __forceinline__ float2 cmul(float2 a, float2 b) { return make_float2(a.x * b.x - a.y * b.y, a.x * b.y + a.y * b.x); }
__device__ __forceinline__ float2 cmulc(float2 a, float2 b) { return make_float2(a.x * b.x + a.y * b.y, a.y * b.x - a.x * b.y); }
typedef float c32 __attribute__((ext_vector_type(2)));
__device__ __forceinline__ c32 cmul_pk(c32 a, c32 b) {
  c32 t, r;
  asm("v_pk_mul_f32 %0, %1, %2 op_sel:[0,0] op_sel_hi:[0,1]" : "=v"(t) : "v"(a), "v"(b));
  asm("v_pk_fma_f32 %0, %1, %2, %3 op_sel:[1,1,0] op_sel_hi:[1,0,1] neg_lo:[0,1,0]" : "=v"(r) : "v"(a), "v"(b), "v"(t));
  return r;
}
__device__ __forceinline__ float2 twid(float turns) { return make_float2(__builtin_amdgcn_cosf(turns), -__builtin_amdgcn_sinf(turns)); }

template <int R, bool INV>
__device__ __forceinline__ void butterflies(c32 (&v)[1 << R], float turns0) {
  constexpr int RAD = 1 << R;
  constexpr float TC[16] = {1.0f, 0.98078528040f, 0.92387953251f, 0.83146961230f, 0.70710678119f, 0.55557023302f, 0.38268343237f, 0.19509032202f,
                            0.0f, -0.19509032202f, -0.38268343237f, -0.55557023302f, -0.70710678119f, -0.83146961230f, -0.92387953251f, -0.98078528040f};
  constexpr float TS[16] = {0.0f, 0.19509032202f, 0.38268343237f, 0.55557023302f, 0.70710678119f, 0.83146961230f, 0.92387953251f, 0.98078528040f,
                            1.0f, 0.98078528040f, 0.92387953251f, 0.83146961230f, 0.70710678119f, 0.55557023302f, 0.38268343237f, 0.19509032202f};
  float2 tbs[R];
  tbs[0] = twid(turns0);
  if (INV) tbs[0].y = -tbs[0].y;
#pragma unroll
  for (int k = 1; k < R; ++k) tbs[k] = cmul(tbs[k - 1], tbs[k - 1]);
#pragma unroll
  for (int kk = 0; kk < R; ++kk) {
    const int k = INV ? (R - 1 - kk) : kk;
    const int hd = RAD >> (k + 1);
#pragma unroll
    for (int j = 0; j < RAD; ++j) {
      if ((j & hd) == 0) {
        const int m = (j & (hd - 1)) * (16 / hd);
        const float2 c = make_float2(TC[m], INV ? TS[m] : -TS[m]);
        const float2 twf = cmul(tbs[k], c);
        const c32 tw = {twf.x, twf.y};
        const c32 a = v[j], b = v[j + hd];
        if (!INV) { v[j] = a + b; v[j + hd] = cmul_pk(a - b, tw); }
        else { const c32 bt = cmul_pk(b, tw); v[j] = a + bt; v[j + hd] = a - bt; }
      }
    }
  }
}
__device__ __forceinline__ float2 unpk2(unsigned w) { return make_float2(bflo(w), bfhi(w)); }
struct NoLd {};
struct NoF { typedef NoLd Ld; __device__ __forceinline__ float2 operator()(int) const { return make_float2(0.f, 0.f); } __device__ __forceinline__ NoLd load(int) const { return NoLd(); } __device__ __forceinline__ void store(int, float2, const NoLd&) const {} };
template <int LOGN, int R, int DLOG, bool INV, int MODE, class F>
__device__ __forceinline__ void fft_pass(float2* X, const F& f) {
  constexpr int RAD = 1 << R, N = 1 << LOGN, dmin = 1 << DLOG, NGR = N >> R;
  constexpr int PSTEP = (DLOG >= 5) ? ((1 << DLOG) + (1 << (DLOG >= 5 ? DLOG - 5 : 0))) : 0;
  int tid0 = threadIdx.x; asm volatile("" : "+v"(tid0));
  c32* Xc = (c32*)X;
  auto gbase = [&](int g) { const int lo = g & (dmin - 1), hi = g >> DLOG; return (hi << (DLOG + R)) + lo; };
  auto fetch = [&](int g, c32 (&dst)[RAD]) {
    const int base = gbase(g);
#pragma unroll
    for (int j = 0; j < RAD; ++j) { if constexpr (MODE == 1) { const float2 sv = f(base + (j << DLOG)); dst[j] = (c32){sv.x, sv.y}; } }
  };
  c32 nxt[RAD];
  if constexpr (MODE == 1) fetch(tid0, nxt);
#pragma unroll 1
  for (int g = tid0; g < NGR; g += 512) {
    const int lo = g & (dmin - 1), base = gbase(g), pb = phys(base);
    c32 v[RAD];
    if constexpr (MODE == 1) {
#pragma unroll
      for (int j = 0; j < RAD; ++j) v[j] = nxt[j];
      if (g + 512 < NGR) fetch(g + 512, nxt);
    } else {
#pragma unroll
      for (int j = 0; j < RAD; ++j) v[j] = Xc[(DLOG >= 5) ? pb + j * PSTEP : phys(base + (j << DLOG))];
    }
    butterflies<R, INV>(v, (float)lo / (float)(RAD << DLOG));
    if constexpr (MODE == 2) {
      typename F::Ld ld[2][4];
#pragma unroll
      for (int j = 0; j < 4; ++j) ld[0][j] = f.load(base + (j << DLOG));
#pragma unroll
      for (int j0 = 0; j0 < RAD; j0 += 4) {
        constexpr int dummy = 0; (void)dummy;
        const int cur = (j0 >> 2) & 1;
        if (j0 + 4 < RAD) {
#pragma unroll
          for (int j = 0; j < 4; ++j) ld[cur ^ 1][j] = f.load(base + ((j0 + 4 + j) << DLOG));
        }
#pragma unroll
        for (int j = 0; j < 4; ++j) f.store(base + ((j0 + j) << DLOG), make_float2(v[j0 + j].x, v[j0 + j].y), ld[cur][j]);
      }
    } else {
#pragma unroll
      for (int j = 0; j < RAD; ++j) Xc[(DLOG >= 5) ? pb + j * PSTEP : phys(base + (j << DLOG))] = v[j];
    }
  }
  __syncthreads();
}
template <int LOGN>
__device__ __forceinline__ void fft_last_to_regs(const float2* X, c32 (&kf)[32]) {
  static_assert(LOGN == 14, "one radix-32 group per thread");
  const c32* Xc = (const c32*)X;
  int tid0 = threadIdx.x; asm volatile("" : "+v"(tid0));
  const int pb = tid0 * 33;
  c32 v[32];
#pragma unroll
  for (int j = 0; j < 32; ++j) v[j] = Xc[pb + j];
  butterflies<5, false>(v, 0.f);
#pragma unroll
  for (int j = 0; j < 32; ++j) kf[j] = v[j];
  __syncthreads();
}
template <int LOGN>
__device__ __forceinline__ void fft_fused_mul(float2* X, const c32 (&kf)[32]) {
  static_assert(LOGN == 14, "one radix-32 group per thread");
  c32* Xc = (c32*)X;
  int tid0 = threadIdx.x; asm volatile("" : "+v"(tid0));
  const int pb = tid0 * 33;
  c32 v[32];
#pragma unroll
  for (int j = 0; j < 32; ++j) v[j] = Xc[pb + j];
  butterflies<5, false>(v, 0.f);
#pragma unroll
  for (int j = 0; j < 32; ++j) v[j] = cmul_pk(v[j], kf[j]);
  butterflies<5, true>(v, 0.f);
#pragma unroll
  for (int j = 0; j < 32; ++j) Xc[pb + j] = v[j];
  __syncthreads();
}
__device__ __forceinline__ float sconv(const bf16_t* row, int t, int L, float w0, float w1, float w2, float b) {
  const int tm = t > 0 ? t - 1 : 0, tp = t + 1 < L ? t + 1 : L - 1;
  const float vm = bf2f(row[tm]), p0 = bf2f(row[t]), vp = bf2f(row[tp]);
  const float pm = t > 0 ? vm : 0.f, pp = t + 1 < L ? vp : 0.f;
  return pm * w0 + p0 * w1 + pp * w2 + b;
}
struct FiltSrc {
  typedef NoLd Ld;
  const bf16_t* hf; const bf16_t* hb; int L; int lshift; int chstride; int half; float invTurn;
  __device__ __forceinline__ float2 operator()(int i) const {
    const int ch = i >> lshift, t = i & (L - 1);
    const float f = bf2f(hf[ch * chstride + t]), bw = bf2f(hb[ch * chstride + (t > 0 ? L - t : 0)]);
    const float bwm = t > 0 ? bw : 0.f;
    if (half == 0) return make_float2(f + bwm, 0.f);
    const float2 tw = twid((float)t * invTurn); const float d = f - bwm; return make_float2(d * tw.x, d * tw.y);
  }
};
struct DataSrc {
  typedef NoLd Ld;
  const unsigned* Wd; int L; int half; float invTurn;
  __device__ __forceinline__ float2 operator()(int i) const { const float2 wv = unpk2(Wd[i]); return half ? cmul(wv, twid((float)(i & (L - 1)) * invTurn)) : wv; }
};
struct YSink { typedef NoLd Ld; unsigned* Yd; float sc; __device__ __forceinline__ NoLd load(int) const { return NoLd(); } __device__ __forceinline__ void store(int i, float2 v, const NoLd&) const { Yd[i] = cvt_pk_bf16(v.x * sc, v.y * sc); } };
struct GateLd { float2 e, wv; float s0, s1; };
struct GateSink {
  typedef GateLd Ld;
  const unsigned* Yd; unsigned* Wd; const bf16_t* gr0; const bf16_t* gr1; bf16_t* o0; bf16_t* o1; int L; int lshift; int rowdiff; int last;
  float invTurn, inv2L; float bias[2], g0[2], g1[2], g2[2], gb[2];
  __device__ __forceinline__ GateLd load(int i) const {
    const int ch = i >> lshift, t = i & (L - 1);
    const float a0 = ch ? g0[1] : g0[0], a1 = ch ? g1[1] : g1[0], a2 = ch ? g2[1] : g2[0], ab = ch ? gb[1] : gb[0];
    GateLd r; r.e = unpk2(Yd[i]); r.wv = unpk2(Wd[i]); r.s0 = sconv(gr0 + (size_t)ch * rowdiff, t, L, a0, a1, a2, ab); r.s1 = sconv(gr1 + (size_t)ch * rowdiff, t, L, a0, a1, a2, ab); return r;
  }
  __device__ __forceinline__ void store(int i, float2 v, const GateLd& r) const {
    const int ch = i >> lshift, t = i & (L - 1);
    const float bs = ch ? bias[1] : bias[0];
    const float2 o = cmulc(v, twid((float)t * invTurn));
    const float y0 = r.s0 * (r.e.x + o.x * inv2L + bs * r.wv.x), y1 = r.s1 * (r.e.y + o.y * inv2L + bs * r.wv.y);
    if (!last) Wd[i] = cvt_pk_bf16(y0, y1);
    else { o0[(size_t)ch * rowdiff + t] = f2bf(y0); o1[(size_t)ch * rowdiff + t] = f2bf(y1); }
  }
};
template <int LOGN, bool DUAL, bool INV, int MODE, class F>
__device__ __forceinline__ void fft_outer(float2* X, const F& f) {
  if constexpr (DUAL) fft_pass<LOGN + 1, 3, LOGN - 3, INV, MODE, F>(X, f);
  else fft_pass<LOGN, 4, LOGN - 4, INV, MODE, F>(X, f);
}
template <int LOGN, bool INV>
__device__ __forceinline__ void fft_mid(float2* X) {
  static_assert(LOGN == 14, "pass structure 4|3 + 5 + 5");
  NoF nf;
  fft_pass<14, 5, 5, INV, 0, NoF>(X, nf);
}
constexpr size_t DO_W = 323 * MiB;
template <int LOGN>
__device__ void hyena_filters(const Params& p, unsigned char* shm, int c0, int cstride) {
  constexpr int L = 1 << LOGN, grp = (LOGN == 13);
  int tid = threadIdx.x; asm volatile("" : "+v"(tid));
  float* sW = (float*)(shm + 135168);
  const float* __restrict__ h3T = (const float*)(p.ws + WS_H3T) + (grp ? (size_t)64 * LP : 0);
  bf16_t* FSb = (bf16_t*)(p.ws + WS_SCR1 + (size_t)blockIdx.x * (512 * 1024));
  const float* fw4 = p.in[18];
  __syncthreads();
  for (int e = tid; e < 1024; e += 512) { const int j = e >> 4, a = e & 15, k = a >> 2, f = a & 3; int c = c0 + k * cstride; if (c > 1023) c = 1023; sW[e] = fw4[(size_t)j * 4096 + f * 1024 + c]; }
  __syncthreads();
  const float dmin_ = -3.0701134573253944f, dmax_ = -15.350567286626973f;
  const float invL1 = 1.0f / (float)(L - 1);
#pragma unroll 1
  for (int t4 = tid * 4; t4 < L; t4 += 2048) {
    f32x4 acc[16];
#pragma unroll
    for (int a = 0; a < 16; ++a) acc[a] = (f32x4){0.f, 0.f, 0.f, 0.f};
#pragma unroll 1
    for (int j0 = 0; j0 < 64; j0 += 8) {
      f32x4 hv[8];
#pragma unroll
      for (int j = 0; j < 8; ++j) hv[j] = *(const f32x4*)(h3T + (size_t)(j0 + j) * L + t4);
#pragma unroll
      for (int j = 0; j < 8; ++j) {
        const f32x4* wp = (const f32x4*)(sW + (j0 + j) * 16);
#pragma unroll
        for (int q = 0; q < 4; ++q) { const f32x4 w = wp[q]; acc[q * 4] += hv[j] * w[0]; acc[q * 4 + 1] += hv[j] * w[1]; acc[q * 4 + 2] += hv[j] * w[2]; acc[q * 4 + 3] += hv[j] * w[3]; }
      }
    }
#pragma unroll
    for (int k = 0; k < 4; ++k) {
      int c = c0 + k * cstride; if (c > 1023) c = 1023;
      const float delta = fabsf(dmin_ + (float)c * ((dmax_ - dmin_) / 1023.0f));
      f32x4 dec;
#pragma unroll
      for (int e = 0; e < 4; ++e) dec[e] = __expf(-(float)(t4 + e) * invL1 * delta);
#pragma unroll
      for (int f = 0; f < 4; ++f) { const f32x4 v = acc[k * 4 + f] * dec; *(u32x2*)(FSb + (size_t)(k * 4 + f) * L + t4) = (u32x2){cvt_pk_bf16(v[0], v[1]), cvt_pk_bf16(v[2], v[3])}; }
    }
  }
  __syncthreads();
}
template <int LOGN, bool DUAL>
__device__ void hyena_unit(const Params& p, unsigned char* shm, int ca, int cb, int ka, int kb) {
  constexpr int L = 1 << LOGN, grp = (LOGN == 13), LOGX = DUAL ? LOGN + 1 : LOGN, LX = 1 << LOGX;
  int tid = threadIdx.x; asm volatile("" : "+v"(tid));
  float2* X = (float2*)shm;
  bf16_t* hyT = (bf16_t*)(p.ws + WS_BIG) + (grp ? (size_t)2 * 3072 * LP : 0);
  const size_t seqstride = (size_t)3072 * L;
  const bf16_t* FS = (const bf16_t*)(p.ws + WS_SCR1 + (size_t)blockIdx.x * (512 * 1024)) + (size_t)ka * 4 * L;
  const int chstride = (kb - ka) * 4 * L, rowdiff = (cb - ca) * L;
  unsigned* Wd = (unsigned*)((unsigned char*)p.out + DO_W + (size_t)blockIdx.x * (128 * 1024));
  unsigned* Yd = (unsigned*)((unsigned char*)p.out + DO_Y + (size_t)blockIdx.x * (128 * 1024));
  const float *cw = p.in[10], *cb_ = p.in[11], *hbias = p.in[20];
  __syncthreads();
  {
    const float w0a = cw[ca], w1a = cw[3072 + ca], w2a = cw[6144 + ca], bba = cb_[ca];
    const float w0b = cw[cb], w1b = cw[3072 + cb], w2b = cw[6144 + cb], bbb = cb_[cb];
    const bf16_t* r0 = hyT + (size_t)ca * L; const bf16_t* r1 = r0 + seqstride;
#pragma unroll 4
    for (int i = tid; i < LX; i += 512) {
      const int ch = i >> LOGN, t = i & (L - 1);
      const float w0 = ch ? w0b : w0a, w1 = ch ? w1b : w1a, w2 = ch ? w2b : w2a, bb = ch ? bbb : bba;
      Wd[i] = cvt_pk_bf16(sconv(r0 + (size_t)ch * rowdiff, t, L, w0, w1, w2, bb), sconv(r1 + (size_t)ch * rowdiff, t, L, w0, w1, w2, bb));
    }
  }
  __syncthreads();
  const float inv2L = 1.0f / (float)(2 * L), invTurn = 1.0f / (float)(2 * L);
#pragma unroll 1
  for (int n = 0; n < 2; ++n) {
    const int gca = (n + 1) * 1024 + ca, gcb = (n + 1) * 1024 + cb;
    GateSink gs; gs.Yd = Yd; gs.Wd = Wd; gs.gr0 = hyT + (size_t)gca * L; gs.gr1 = gs.gr0 + seqstride; gs.o0 = hyT + (size_t)ca * L; gs.o1 = gs.o0 + seqstride;
    gs.L = L; gs.lshift = LOGN; gs.rowdiff = rowdiff; gs.last = n; gs.invTurn = invTurn; gs.inv2L = inv2L;
    gs.bias[0] = hbias[n * 1024 + ca]; gs.bias[1] = hbias[n * 1024 + cb];
    gs.g0[0] = cw[gca]; gs.g1[0] = cw[3072 + gca]; gs.g2[0] = cw[6144 + gca]; gs.gb[0] = cb_[gca];
    gs.g0[1] = cw[gcb]; gs.g1[1] = cw[3072 + gcb]; gs.g2[1] = cw[6144 + gcb]; gs.gb[1] = cb_[gcb];
#pragma unroll 1
    for (int half = 0; half < 2; ++half) {
      c32 kf[32];
      FiltSrc fs; fs.hf = FS + (size_t)(2 * n) * L; fs.hb = fs.hf + L; fs.L = L; fs.lshift = LOGN; fs.chstride = chstride; fs.half = half; fs.invTurn = invTurn;
      fft_outer<LOGN, DUAL, false, 1>(X, fs);
      fft_mid<LOGX, false>(X);
      fft_last_to_regs<LOGX>(X, kf);
      DataSrc ds; ds.Wd = Wd; ds.L = L; ds.half = half; ds.invTurn = invTurn;
      fft_outer<LOGN, DUAL, false, 1>(X, ds);
      fft_mid<LOGX, false>(X);
      fft_fused_mul<LOGX>(X, kf);
      fft_mid<LOGX, true>(X);
      if (half == 0) { YSink ys; ys.Yd = Yd; ys.sc = inv2L; fft_outer<LOGN, DUAL, true, 2>(X, ys); }
      else fft_outer<LOGN, DUAL, true, 2>(X, gs);
    }
  }
}

constexpr int KP = 136, VP = 200;
struct AttItem { int tokbase, Ls, hc, dil, r, nb, gh; };
__device__ __forceinline__ AttItem att_decode(int it) {
  int seq, rem, L, tokbase;
  if (it < 6144) { seq = it / 3072; rem = it - seq * 3072; L = LP; tokbase = seq * LP; }
  else { const int i2 = it - 6144; seq = i2 / 1536; rem = i2 - seq * 1536; L = LSQ; tokbase = MP + seq * LSQ; }
  const int nblk = L / 64, hd = rem / nblk, blk = rem - hd * nblk, g = hd >> 2, h = hd & 3;
  const int dil = g == 0 ? 1 : (g == 1 ? 4 : 16), nbn = nblk / dil, r = blk / nbn, nb = blk - r * nbn;
  AttItem a; a.tokbase = tokbase; a.Ls = L / dil; a.hc = g * 512 + h * 128; a.dil = dil; a.r = r; a.nb = nb; a.gh = g * 4 + h; return a;
}
__device__ __forceinline__ void att_load(const Params& p, const AttItem& a, int tid, u32x4 (&kq)[8], u32x4 (&vv)[6]) {
  const bf16_t* qg = (const bf16_t*)((unsigned char*)p.out + DO_Q);
  const bf16_t* kg = (const bf16_t*)((unsigned char*)p.out + DO_K);
  const bf16_t* vg = (const bf16_t*)(p.ws + WS_V);
  const int s0 = (a.nb - 1) * 64;
#pragma unroll
  for (int i = 0; i < 8; ++i) {
    const int e = tid + i * 512, row = e >> 4, ch = e & 15;
    u32x4 val = {0u, 0u, 0u, 0u};
    if (row < 192) { const int s = s0 + row; if (s >= 0 && s < a.Ls) val = *(const u32x4*)(kg + (size_t)(a.tokbase + s * a.dil + a.r) * DATT + a.hc + ch * 8); }
    else val = *(const u32x4*)(qg + (size_t)(a.tokbase + (a.nb * 64 + row - 192) * a.dil + a.r) * DATT + a.hc + ch * 8);
    kq[i] = val;
  }
#pragma unroll
  for (int i = 0; i < 6; ++i) {
    const int e = tid + i * 512, ch = e / 192, row = e - ch * 192, s = s0 + row;
    u32x4 val = {0u, 0u, 0u, 0u};
    if (s >= 0 && s < a.Ls) val = *(const u32x4*)(vg + (size_t)(a.tokbase + s * a.dil + a.r) * DATT + a.hc + ch * 8);
    vv[i] = val;
  }
}
__device__ void attention_phase(const Params& p, unsigned char* shm) {
  int tid = threadIdx.x; asm volatile("" : "+v"(tid));
  const int lane = tid & 63, wid = tid >> 6, fr = lane & 15, fq = lane >> 4;
  bf16_t* Ks = (bf16_t*)shm;
  bf16_t* Qs = Ks + 192 * KP;
  bf16_t* Vt = Qs + 64 * KP;
  bf16_t* qg = (bf16_t*)((unsigned char*)p.out + DO_Q);
  float* lse = (float*)((unsigned char*)p.out + DO_LSE);
  u32x4 kq[8], vv[6];
  int it = blockIdx.x;
  if (it >= 9216) return;
  AttItem a = att_decode(it);
  att_load(p, a, tid, kq, vv);
#pragma unroll 1
  for (;;) {
    __syncthreads();
#pragma unroll
    for (int i = 0; i < 8; ++i) { const int e = tid + i * 512, row = e >> 4, ch = e & 15; *(u32x4*)(Ks + row * KP + ch * 8) = kq[i]; }
#pragma unroll
    for (int i = 0; i < 6; ++i) {
      const int e = tid + i * 512, ch = e / 192, row = e - ch * 192;
#pragma unroll
      for (int j = 0; j < 4; ++j) { Vt[(ch * 8 + 2 * j) * VP + row] = (bf16_t)(vv[i][j] & 0xffffu); Vt[(ch * 8 + 2 * j + 1) * VP + row] = (bf16_t)(vv[i][j] >> 16); }
    }
    __syncthreads();
    const AttItem cur = a;
    const int itn = it + gridDim.x;
    const bool has_next = itn < 9216;
    if (has_next) { a = att_decode(itn); att_load(p, a, tid, kq, vv); }
    const int qt = __builtin_amdgcn_readfirstlane(wid & 3), dh = __builtin_amdgcn_readfirstlane(wid >> 2), s0 = (cur.nb - 1) * 64;
    bf16x8 qf[4];
#pragma unroll
    for (int ks = 0; ks < 4; ++ks) qf[ks] = *(const bf16x8*)(Qs + (qt * 16 + fr) * KP + ks * 32 + fq * 8);
    f32x4 sc[12];
#pragma unroll
    for (int kt = 0; kt < 12; ++kt) {
      f32x4 acc = {0.f, 0.f, 0.f, 0.f};
      if (kt >= qt && kt <= qt + 8) {
#pragma unroll
        for (int ks = 0; ks < 4; ++ks) { const bf16x8 kf = *(const bf16x8*)(Ks + (kt * 16 + fr) * KP + ks * 32 + fq * 8); acc = __builtin_amdgcn_mfma_f32_16x16x32_bf16(kf, qf[ks], acc, 0, 0, 0); }
      }
      sc[kt] = acc;
    }
    const int qi = qt * 16 + fr;
    const float scale = 0.08838834764831845f;
    float mx = -3.0e38f;
#pragma unroll
    for (int kt = 0; kt < 12; ++kt)
#pragma unroll
      for (int j = 0; j < 4; ++j) {
        const int kk = kt * 16 + fq * 4 + j, s = s0 + kk;
        const bool ok = (kk >= qi) && (kk <= qi + 128) && (s >= 0) && (s < cur.Ls);
        const float v = ok ? sc[kt][j] * scale : -1e30f;
        sc[kt][j] = v; mx = fmaxf(mx, v);
      }
    mx = fmaxf(mx, __shfl_xor(mx, 16)); mx = fmaxf(mx, __shfl_xor(mx, 32));
    float sum = 0.f;
#pragma unroll
    for (int kt = 0; kt < 12; ++kt)
#pragma unroll
      for (int j = 0; j < 4; ++j) { const float pv = __expf(sc[kt][j] - mx); sc[kt][j] = pv; sum += pv; }
    sum += __shfl_xor(sum, 16); sum += __shfl_xor(sum, 32);
    const float inv = 1.0f / sum;
    f32x4 oacc[4];
#pragma unroll
    for (int dt = 0; dt < 4; ++dt) oacc[dt] = (f32x4){0.f, 0.f, 0.f, 0.f};
#pragma unroll
    for (int kb = 0; kb < 6; ++kb) {
      u32x4 pw; pw.x = cvt_pk_bf16(sc[2 * kb][0], sc[2 * kb][1]); pw.y = cvt_pk_bf16(sc[2 * kb][2], sc[2 * kb][3]); pw.z = cvt_pk_bf16(sc[2 * kb + 1][0], sc[2 * kb + 1][1]); pw.w = cvt_pk_bf16(sc[2 * kb + 1][2], sc[2 * kb + 1][3]);
      const bf16x8 pf = __builtin_bit_cast(bf16x8, pw);
#pragma unroll
      for (int dt = 0; dt < 4; ++dt) {
        const bf16_t* vr = Vt + (dh * 64 + dt * 16 + fr) * VP + kb * 32 + fq * 4;
        const u32x2 lo = *(const u32x2*)vr, hi = *(const u32x2*)(vr + 16);
        const u32x4 vw = {lo.x, lo.y, hi.x, hi.y};
        oacc[dt] = __builtin_amdgcn_mfma_f32_16x16x32_bf16(__builtin_bit_cast(bf16x8, vw), pf, oacc[dt], 0, 0, 0);
      }
    }
    const size_t tok = (size_t)(cur.tokbase + (cur.nb * 64 + qi) * cur.dil + cur.r);
#pragma unroll
    for (int dt = 0; dt < 4; ++dt) {
      const unsigned w0 = cvt_pk_bf16(oacc[dt][0] * inv, oacc[dt][1] * inv), w1 = cvt_pk_bf16(oacc[dt][2] * inv, oacc[dt][3] * inv);
      *(u32x2*)(qg + tok * DATT + cur.hc + dh * 64 + dt * 16 + fq * 4) = (u32x2){w0, w1};
    }
    if (dh == 0 && fq == 0) lse[tok * 12 + cur.gh] = mx + __logf(sum);
    if (!has_next) break;
    it = itn;
  }
  __syncthreads();
}

__device__ void transpose_hy(const Params& p, unsigned char* shm) {
  bf16_t* tile = (bf16_t*)shm;
  const bf16_t* hyT = (const bf16_t*)(p.ws + WS_BIG);
  bf16_t* hy = (bf16_t*)((unsigned char*)p.out + DO_HY);
  int tid = threadIdx.x; asm volatile("" : "+v"(tid));
  const int ntile = (MT / 64) * 16;
  for (int t = blockIdx.x; t < ntile; t += gridDim.x) {
    const int ct = t & 15, tt = t >> 4, tok0 = tt * 64;
    const bf16_t* src; int L;
    if (tok0 < MP) { L = LP; src = hyT + (size_t)(tok0 >> 14) * 3072 * LP + (tok0 & (LP - 1)); }
    else { L = LSQ; const int tk = tok0 - MP; src = hyT + (size_t)2 * 3072 * LP + (size_t)(tk >> 13) * 3072 * LSQ + (tk & (LSQ - 1)); }
    __syncthreads();
#pragma unroll
    for (int i = 0; i < 4; ++i) { const int e = tid + i * 512, cr = e >> 5, tp = (e & 31) * 2; *(unsigned*)(tile + cr * 66 + tp) = *(const unsigned*)(src + (size_t)(ct * 64 + cr) * L + tp); }
    __syncthreads();
#pragma unroll
    for (int i = 0; i < 4; ++i) { const int e = tid + i * 512, tr = e >> 5, cp = (e & 31) * 2;
      const unsigned w = (unsigned)tile[cp * 66 + tr] | ((unsigned)tile[(cp + 1) * 66 + tr] << 16);
      *(unsigned*)(hy + (size_t)(tok0 + tr) * DHY + ct * 64 + cp) = w; }
  }
  __syncthreads();
}
__device__ void combine_att(const Params& p) {
  const bf16_t* o = (const bf16_t*)((unsigned char*)p.out + DO_Q);
  const float* lse = (const float*)((unsigned char*)p.out + DO_LSE);
  bf16_t* att = (bf16_t*)(p.ws + WS_V);
  int tid = threadIdx.x; asm volatile("" : "+v"(tid));
  const int gt = blockIdx.x * 512 + tid, gs = gridDim.x * 512;
  for (int e = gt; e < MT * 64; e += gs) {
    const int tok = e >> 6, h = (e >> 4) & 3, ch = e & 15;
    const float l0 = lse[tok * 12 + h], l1 = lse[tok * 12 + 4 + h], l2 = lse[tok * 12 + 8 + h];
    const float m = fmaxf(l0, fmaxf(l1, l2));
    float w0 = __expf(l0 - m), w1 = __expf(l1 - m), w2 = __expf(l2 - m);
    const float is = 1.0f / (w0 + w1 + w2); w0 *= is; w1 *= is; w2 *= is;
    const bf16_t* op = o + (size_t)tok * DATT + h * 128 + ch * 8;
    const u32x4 a = *(const u32x4*)op, b = *(const u32x4*)(op + 512), c = *(const u32x4*)(op + 1024);
    u32x4 r;
#pragma unroll
    for (int i = 0; i < 4; ++i) r[i] = cvt_pk_bf16(w0 * bflo(a[i]) + w1 * bflo(b[i]) + w2 * bflo(c[i]), w0 * bfhi(a[i]) + w1 * bfhi(b[i]) + w2 * bfhi(c[i]));
    *(u32x4*)(att + (size_t)tok * DAO + h * 128 + ch * 8) = r;
  }
}


#define XB_TMO      128
#define XB_XCNT(j)  (256  + 64 * (j))
#define XB_XSUB(j)  (1280 + 64 * (j))
#define XB_XGEN(j)  (2304 + 64 * (j))
#define XB_TOP      3328
#define XB_TOPGEN   3392
#define XCD_BAR_WORDS 3456
#define XB_SPIN_CAP (1u << 18)
__device__ __forceinline__ unsigned xb_ld(unsigned* p)              { return __hip_atomic_load(p, __ATOMIC_RELAXED, __HIP_MEMORY_SCOPE_AGENT); }
__device__ __forceinline__ unsigned xb_add(unsigned* p, unsigned v) { return __hip_atomic_fetch_add(p, v, __ATOMIC_RELAXED, __HIP_MEMORY_SCOPE_AGENT); }
__device__ __forceinline__ unsigned xb_xcc_id() { return (unsigned)__builtin_amdgcn_s_getreg((3 << 11) | 20) & 0xFu; }
#define XB_SPIN(cond, bar) do { unsigned _sp = 0; while (cond) { __builtin_amdgcn_s_sleep(1); \
    if ((++_sp & 255u) == 0u) { if (xb_ld(&(bar)[XB_TMO])) break; if (_sp > XB_SPIN_CAP) { atomicAdd(&(bar)[XB_TMO], 1u); break; } } } } while (0)
struct XcdBarrier { unsigned* bar; unsigned x; volatile LAS unsigned* st; };
__device__ __forceinline__ XcdBarrier xcd_barrier_post(unsigned* bar, volatile LAS unsigned* st) {
  XcdBarrier b; b.bar = bar; b.x = xb_xcc_id(); b.st = st;
  if (threadIdx.x == 0) (void)xb_add(&bar[XB_XCNT(b.x)], 1u);
  return b;
}
__device__ __forceinline__ void xcd_barrier_complete(unsigned* bar, unsigned x, unsigned& nloc, unsigned& nx) {
  const unsigned G = gridDim.x * gridDim.y * gridDim.z;
  unsigned sum, cnt, mine, sp = 0u;
  for (;;) {
    sum = 0u; cnt = 0u; mine = 0u;
#pragma unroll
    for (unsigned j = 0; j < 16; ++j) { const unsigned c = xb_ld(&bar[XB_XCNT(j)]); sum += c; cnt += (c > 0u) ? 1u : 0u; mine = (j == x) ? c : mine; }
    if (sum == G) break;
    __builtin_amdgcn_s_sleep(1);
    if ((++sp & 255u) == 0u) { if (xb_ld(&bar[XB_TMO])) break; if (sp > XB_SPIN_CAP) { atomicAdd(&bar[XB_TMO], 1u); break; } }
  }
  nloc = mine > 0u ? mine : 1u; nx = cnt > 0u ? cnt : 1u;
}
__device__ __forceinline__ void xcd_barrier(const XcdBarrier& b) {
  asm volatile("s_waitcnt vmcnt(0)" ::: "memory");
  __syncthreads();
  if (threadIdx.x == 0) {
    unsigned* bar = b.bar;
    __builtin_amdgcn_s_waitcnt(0);
    unsigned nloc = b.st[0], nx = b.st[1];
    if (nloc == 0u) { xcd_barrier_complete(bar, b.x, nloc, nx); b.st[0] = nloc; b.st[1] = nx; }
    const unsigned old = xb_add(&bar[XB_XSUB(b.x)], 1u);
    const unsigned gen = old / nloc;
    if (old + 1u == (gen + 1u) * nloc) {
      __builtin_amdgcn_fence(__ATOMIC_RELEASE, "agent");
      asm volatile("s_waitcnt vmcnt(0)" ::: "memory");
      const unsigned og = xb_add(&bar[XB_TOP], 1u);
      const unsigned tg = og / nx;
      if (og + 1u == (tg + 1u) * nx) xb_add(&bar[XB_TOPGEN], 1u);
      else XB_SPIN(xb_ld(&bar[XB_TOPGEN]) == tg, bar);
      __builtin_amdgcn_fence(__ATOMIC_ACQUIRE, "agent");
      xb_add(&bar[XB_XGEN(b.x)], 1u);
      asm volatile("s_waitcnt vmcnt(0)" ::: "memory");
    } else {
      XB_SPIN(xb_ld(&bar[XB_XGEN(b.x)]) == gen, bar);
      __builtin_amdgcn_fence(__ATOMIC_ACQUIRE, "agent");
      asm volatile("s_waitcnt vmcnt(0)" ::: "memory");
    }
  }
  __syncthreads();
}

constexpr int NPHASE = 14;
__global__ void __launch_bounds__(512, 2) fwd_mega(Params p) {
  extern __shared__ __attribute__((aligned(16))) unsigned char shm[];
  cg::grid_group grid = cg::this_grid();
  unsigned char* ws = p.ws; unsigned char* ob = (unsigned char*)p.out;
  bf16_t* XN = (bf16_t*)(ws + WS_XN); bf16_t* DELTA = (bf16_t*)(ws + WS_DELTA);
  volatile LAS unsigned* xst = (volatile LAS unsigned*)(LAS unsigned char*)(shm + LDS_BYTES - 16);
  if (threadIdx.x == 0) { xst[0] = 0u; xst[1] = 0u; }
  __syncthreads();
  const XcdBarrier xb = xcd_barrier_post((unsigned*)(ws + WS_BAR), xst);
#ifndef DUPMASK
#define DUPMASK 0
#endif
  for (int ph = p.ph_lo; ph < p.ph_hi; ++ph) {
    if (ph != p.ph_lo) { if (ph == p.ph_lo + 1) grid.sync(); else xcd_barrier(xb); }
    for (int rep = 0; rep < (((DUPMASK >> ph) & 1) ? 2 : 1); ++rep)
    switch (ph) {
      case 0: {
        convert_wt(shm, p.in[4], DM, DFF, 0, DFF, (bf16_t*)(ws + WS_WFFN), 256, 0);
        convert_wt(shm, p.in[5], DM, DFF, 0, DFF, (bf16_t*)(ws + WS_WFFN), 256, 128);
        convert_wt(shm, p.in[6], DFF, DM, 0, DM, (bf16_t*)(ws + WS_WD), 128, 0);
        row_pass<0>(p, nullptr, 0, p.in[2], nullptr, nullptr, XN, nullptr);
        make_tables(p);
      } break;
      case 1: case 11: {
        pg8::EpiSwiGLU E; E.H = (bf16_t*)(ws + WS_BIG);
        run_gemm(shm, XN, (const bf16_t*)(ws + WS_WFFN), MT, 2 * DFF, DM, E, (unsigned*)(ws + WS_QCNT) + (ph) * 128, (int)xb.x);
      } break;
      case 2: case 12: {
        pg8::EpiBf16 E; E.O = XN; E.ldc = DM;
        run_gemm<pg8::EpiBf16, true>(shm, (const bf16_t*)(ws + WS_BIG), (const bf16_t*)(ws + WS_WD), MT, DM, DFF, E, (unsigned*)(ws + WS_QCNT) + (ph) * 128, (int)xb.x);
      } break;
      case 3: {
        row_pass<1>(p, XN, DM, p.in[3], p.in[7], DELTA, XN, nullptr);
        convert_wt(shm, p.in[9], DM, 11776, 0, 7680, (bf16_t*)(ws + WS_WINHQ), 128, 0);
        convert_wt(shm, p.in[9], DM, 11776, 7680, 2048, (bf16_t*)(ws + WS_WGATES), 256, 0);
        convert_wt(shm, p.in[9], DM, 11776, 9728, 2048, (bf16_t*)(ws + WS_WGATES), 256, 128);
        convert_wt(shm, p.in[21], DHY, DM, 0, DM, (bf16_t*)(ws + WS_WHP), 128, 0);
        convert_wt(shm, p.in[22], DAO, DM, 0, DM, (bf16_t*)(ws + WS_WAP), 128, 0);
        convert_wt(shm, p.in[23], DM, DM, 0, DM, (bf16_t*)(ws + WS_WOUT), 128, 0);
      } break;
      case 4: {
        pg8::EpiInProj E; E.hyT = (bf16_t*)(ws + WS_BIG); E.q = (bf16_t*)(ob + DO_Q); E.k = (bf16_t*)(ob + DO_K); E.v = (bf16_t*)(ws + WS_V); E.rope = (const float2*)(ws + WS_ROPE); E.tl = (LAS unsigned char*)shm + pg8::STAGE_BYTES;
        run_gemm(shm, XN, (const bf16_t*)(ws + WS_WINHQ), MT, 7680, DM, E, (unsigned*)(ws + WS_QCNT) + (ph) * 128, (int)xb.x);
      } break;
      case 5: {
        for (int c0 = blockIdx.x; c0 < 1024; c0 += 4 * gridDim.x) {
          hyena_filters<14>(p, shm, c0, gridDim.x);
          for (int k = 0; k < 4; ++k) if (c0 + k * (int)gridDim.x < 1024) hyena_unit<14, false>(p, shm, c0 + k * gridDim.x, c0 + k * gridDim.x, k, k);
        }
        for (int c0 = blockIdx.x; c0 < 1024; c0 += 4 * gridDim.x) {
          hyena_filters<13>(p, shm, c0, gridDim.x);
          for (int k = 0; k < 4; k += 2) {
            const int ca = c0 + k * (int)gridDim.x; int cb = ca + (int)gridDim.x, kb = k + 1;
            if (cb >= 1024) { cb = ca; kb = k; }
            if (ca < 1024) hyena_unit<13, true>(p, shm, ca, cb, k, kb);
          }
        }
        attention_phase(p, shm);
      } break;
      case 6: {
        transpose_hy(p, shm);
        combine_att(p);
      } break;
      case 7: {
        pg8::EpiTiled E; E.O = (bf16_t*)(ws + WS_BIG);
        run_gemm(shm, (const bf16_t*)(ob + DO_HY), (const bf16_t*)(ws + WS_WHP), MT, DM, DHY, E, (unsigned*)(ws + WS_QCNT) + (ph) * 128, (int)xb.x);
        pg8::EpiTiled E2; E2.O = (bf16_t*)(ws + WS_B);
        run_gemm(shm, (const bf16_t*)(ws + WS_V), (const bf16_t*)(ws + WS_WAP), MT, DM, DAO, E2, (unsigned*)(ws + WS_QCNT) + (14) * 128, (int)xb.x);
      } break;
      case 8: {
        pg8::EpiMerge E; E.Aa = (const bf16_t*)(ws + WS_BIG); E.Bb = (const bf16_t*)(ws + WS_B); E.O = (bf16_t*)(ob + DO_MERGED);
        run_gemm(shm, XN, (const bf16_t*)(ws + WS_WGATES), MT, 4096, DM, E, (unsigned*)(ws + WS_QCNT) + (ph) * 128, (int)xb.x);
      } break;
      case 9: {
        pg8::EpiBf16 E; E.O = XN; E.ldc = DM;
        run_gemm(shm, (const bf16_t*)(ob + DO_MERGED), (const bf16_t*)(ws + WS_WOUT), MT, DM, DM, E, (unsigned*)(ws + WS_QCNT) + (ph) * 128, (int)xb.x);
      } break;
      case 10: {
        row_pass<2>(p, XN, DM, p.in[8], p.in[24], DELTA, XN, nullptr);
        convert_wt(shm, p.in[26], DM, DFF, 0, DFF, (bf16_t*)(ws + WS_WFFN), 256, 0);
        convert_wt(shm, p.in[27], DM, DFF, 0, DFF, (bf16_t*)(ws + WS_WFFN), 256, 128);
        convert_wt(shm, p.in[28], DFF, DM, 0, DM, (bf16_t*)(ws + WS_WD), 128, 0);
      } break;
      case 13: {
        row_pass<3>(p, XN, DM, p.in[25], nullptr, DELTA, nullptr, p.out);
      } break;
    }
  }
}

extern "C" void kernel_launch(void* const* d_in, const int* in_sizes, int n_in, void* d_out, int out_size, void* d_ws, size_t ws_size, hipStream_t stream) {
  static int grid_blocks = 0;
  if (!grid_blocks) {
    int dev = 0, cus = 0, per_cu = 0;
    (void)hipGetDevice(&dev);
    (void)hipDeviceGetAttribute(&cus, hipDeviceAttributeMultiprocessorCount, dev);
    (void)hipFuncSetAttribute((const void*)fwd_mega, hipFuncAttributeMaxDynamicSharedMemorySize, LDS_BYTES);
    (void)hipOccupancyMaxActiveBlocksPerMultiprocessor(&per_cu, (const void*)fwd_mega, 512, LDS_BYTES);
    if (per_cu < 1) per_cu = 1;
    grid_blocks = cus * per_cu;
    if (n_in != 29 || ws_size < WS_NEED) { fprintf(stderr, "kernel_launch: unexpected n_in %d or ws %zu\n", n_in, ws_size); grid_blocks = -1; }
  }
  if (grid_blocks < 0) return;
  (void)hipMemsetAsync((unsigned char*)d_ws + WS_BAR, 0, 32768, stream);
  Params p{};
  for (int i = 0; i < 29; ++i) p.in[i] = (const float*)d_in[i];
  p.out = (float*)d_out; p.ws = (unsigned char*)d_ws; p.ph_lo = 0; p.ph_hi = NPHASE;
  void* args[] = {&p};
  hipError_t e = hipLaunchCooperativeKernel((void*)fwd_mega, dim3(grid_blocks), dim3(512), args, LDS_BYTES, stream);
  if (e != hipSuccess) fprintf(stderr, "cooperative launch failed: %s (grid %d)\n", hipGetErrorString(e), grid_blocks);
}
```
